# Optimizing an MI355X kernel written in HIP

```python
import jax, jax.numpy as jnp
from jax import lax
import numpy as np

D_MODEL = 2048
BATCH = 2
SEQ = 4096
DEPTH = 4

RET_HEADS = 8
RET_QK_DIM = D_MODEL // 16
RET_V_DIM = 2 * RET_QK_DIM
RET_QK_WIDTH = RET_HEADS * RET_QK_DIM
RET_V_WIDTH = RET_HEADS * RET_V_DIM
RET_CHUNK = 128
RET_ROT_BASE = 10000.0
SWA_HEAD_DIM = 64
SWA_Q_HEADS = D_MODEL // SWA_HEAD_DIM
SWA_KV_HEADS = 8
SWA_Q_WIDTH = SWA_Q_HEADS * SWA_HEAD_DIM
SWA_KV_WIDTH = SWA_KV_HEADS * SWA_HEAD_DIM
SWA_WINDOW = 128
SWA_BLOCK = 128
IN_SPLITS = (RET_QK_WIDTH, RET_QK_WIDTH, RET_V_WIDTH, RET_V_WIDTH,
             SWA_Q_WIDTH, SWA_KV_WIDTH, SWA_KV_WIDTH, SWA_Q_WIDTH,
             D_MODEL, D_MODEL)
IN_WIDTH = sum(IN_SPLITS)
EPS = 1e-6

kernel_name = "hybrid_retention_swa_sink_adaln"


def rms_norm(x, w):
    xf = x.astype(jnp.float32)
    y = xf * lax.rsqrt(jnp.mean(xf * xf, axis=-1, keepdims=True) + EPS)
    return (y * w.astype(jnp.float32)).astype(x.dtype)


def rotate(x, pos):
    half = x.shape[-1] // 2
    inv = 1.0 / (RET_ROT_BASE ** jnp.linspace(0.0, 1.0, half, dtype=jnp.float32))
    ang = pos[:, None] * inv[None, :]
    cos = jnp.cos(ang)[None, :, None, :]
    sin = jnp.sin(ang)[None, :, None, :]
    x1, x2 = x[..., :half], x[..., half:]
    return jnp.concatenate([x1 * cos - x2 * sin, x2 * cos + x1 * sin], axis=-1)


def retention(q, k, v):
    b, s, h, _ = q.shape
    nc = s // RET_CHUNK
    log_g = jnp.log1p(-jnp.exp2(-5.0 - jnp.arange(h, dtype=jnp.float32)))
    idx = jnp.arange(RET_CHUNK, dtype=jnp.float32)
    rel = idx[:, None] - idx[None, :]
    decay = jnp.where(rel >= 0, jnp.exp(log_g[:, None, None] * jnp.maximum(rel, 0.0)), 0.0)
    xi = jnp.exp(log_g[None, :] * (idx[:, None] + 1.0))[None, :, :, None]
    zeta = jnp.exp(log_g[None, :] * (RET_CHUNK - 1.0 - idx[:, None]))[None, :, :, None]
    g_chunk = jnp.exp(log_g * RET_CHUNK)[None, :, None, None]

    def to_chunks(t):
        return jnp.moveaxis(t.reshape(b, nc, RET_CHUNK, h, t.shape[-1]), 1, 0)

    def step(state, inp):
        qc, kc, vc = inp
        scores = jnp.einsum('bnhd,bmhd->bhnm', qc, kc) * decay
        inner = jnp.einsum('bhnm,bmhe->bnhe', scores, vc)
        cross = jnp.einsum('bnhd,bhde->bnhe', qc, state) * xi
        new_state = state * g_chunk + jnp.einsum('bmhd,bmhe->bhde', kc * zeta, vc)
        return new_state, inner + cross

    s0 = jnp.zeros((b, h, q.shape[-1], v.shape[-1]), jnp.float32)
    _, out = lax.scan(step, s0, (to_chunks(q), to_chunks(k), to_chunks(v)))
    return jnp.moveaxis(out, 0, 1).reshape(b, s, h, v.shape[-1])


def sliding_window_attention(q, k, v, sinks):
    b, s, hq, dh = q.shape
    hkv = k.shape[2]
    g = hq // hkv
    nb = s // SWA_BLOCK
    qb = q.reshape(b, nb, SWA_BLOCK, hkv, g, dh)

    def band(t):
        tb = t.reshape(b, nb, SWA_BLOCK, hkv, dh)
        prev = jnp.pad(tb, ((0, 0), (1, 0), (0, 0), (0, 0), (0, 0)))[:, :-1]
        return jnp.concatenate([prev, tb], axis=2)

    kb, vb = band(k), band(v)
    scores = jnp.einsum('bnqhgd,bnkhd->bnhgqk', qb, kb).astype(jnp.float32) * (dh ** -0.5)
    qi = jnp.arange(SWA_BLOCK)[:, None]
    ki = jnp.arange(2 * SWA_BLOCK)[None, :]
    dist = qi + SWA_BLOCK - ki
    in_window = (dist >= 0) & (dist < SWA_WINDOW)
    not_first = (jnp.arange(nb) > 0)[:, None, None]
    allowed = in_window[None] & (not_first | (ki >= SWA_BLOCK)[None])
    scores = jnp.where(allowed[None, :, None, None], scores, -jnp.inf)
    sink = sinks.astype(jnp.float32).reshape(hkv, g)[None, None, :, :, None, None]
    m = jnp.maximum(jnp.max(scores, axis=-1, keepdims=True), sink)
    p = jnp.exp(scores - m)
    probs = (p / (jnp.sum(p, axis=-1, keepdims=True) + jnp.exp(sink - m))).astype(v.dtype)
    out = jnp.einsum('bnhgqk,bnkhd->bnqhgd', probs, vb)
    return out.reshape(b, s, hq * dh)


def hybrid_layer(x, c_act, pos, norm_w, ada_w, ada_b, w_in, ret_gn_w, sinks, w_ret_o, w_swa_o, w_out):
    b, s, _ = x.shape
    shift, scale, gate = jnp.split(c_act @ ada_w + ada_b, 3, axis=-1)
    u = rms_norm(x, norm_w) * (1.0 + scale[:, None, :]) + shift[:, None, :]
    proj = u @ w_in
    offsets = []
    acc = 0
    for w in IN_SPLITS[:-1]:
        acc += w
        offsets.append(acc)
    rq, rk, rv, rg, sq, sk, sv, sg, mg_ret, mg_swa = jnp.split(proj, offsets, axis=-1)

    rq = rotate(rq.reshape(b, s, RET_HEADS, RET_QK_DIM).astype(jnp.float32), pos)
    rk = rotate(rk.reshape(b, s, RET_HEADS, RET_QK_DIM).astype(jnp.float32), pos) * (RET_QK_DIM ** -0.5)
    rv = rv.reshape(b, s, RET_HEADS, RET_V_DIM).astype(jnp.float32)
    r = retention(rq, rk, rv)
    mu = jnp.mean(r, axis=-1, keepdims=True)
    var = jnp.mean(jnp.square(r - mu), axis=-1, keepdims=True)
    r = ((r - mu) * lax.rsqrt(var + EPS)).reshape(b, s, RET_V_WIDTH)
    r = (r * ret_gn_w.astype(jnp.float32)).astype(x.dtype) * jax.nn.silu(rg)
    ret_y = r @ w_ret_o

    a = sliding_window_attention(sq.reshape(b, s, SWA_Q_HEADS, SWA_HEAD_DIM),
                                 sk.reshape(b, s, SWA_KV_HEADS, SWA_HEAD_DIM),
                                 sv.reshape(b, s, SWA_KV_HEADS, SWA_HEAD_DIM), sinks)
    swa_y = (a * jax.nn.silu(sg)) @ w_swa_o

    merged = jax.nn.sigmoid(mg_ret) * ret_y + jax.nn.sigmoid(mg_swa) * swa_y
    return x + gate[:, None, :] * (merged @ w_out)


def setup_inputs(seed: int = 0) -> dict:
    key = jax.random.key(seed)
    ks = jax.random.split(key, 14)
    d = D_MODEL
    f32 = jnp.float32
    nrm = lambda k, shape: jax.random.normal(k, shape, f32)
    return {
        "x": nrm(ks[0], (BATCH, SEQ, d)),
        "c": nrm(ks[1], (BATCH, d)),
        "norm_w": 1.0 + 0.02 * nrm(ks[2], (DEPTH, d)),
        "ada_w": nrm(ks[3], (DEPTH, d, 3 * d)) * (0.5 * d ** -0.5),
        "ada_b": 0.01 * nrm(ks[4], (DEPTH, 3 * d)),
        "w_in": nrm(ks[5], (DEPTH, d, IN_WIDTH)) * (d ** -0.5),
        "ret_gn_w": 1.0 + 0.02 * nrm(ks[6], (DEPTH, RET_V_WIDTH)),
        "attn_sinks": nrm(ks[7], (DEPTH, SWA_Q_HEADS)),
        "w_ret_o": nrm(ks[8], (DEPTH, RET_V_WIDTH, d)) * (RET_V_WIDTH ** -0.5),
        "w_swa_o": nrm(ks[9], (DEPTH, SWA_Q_WIDTH, d)) * (SWA_Q_WIDTH ** -0.5),
        "w_out": nrm(ks[10], (DEPTH, d, d)) * (d ** -0.5),
        "final_norm_w": 1.0 + 0.02 * nrm(ks[11], (d,)),
    }


def reference(x, c, norm_w, ada_w, ada_b, w_in, ret_gn_w, attn_sinks, w_ret_o, w_swa_o, w_out, final_norm_w):
    c_act = jax.nn.silu(c)
    pos = jnp.arange(x.shape[1], dtype=jnp.float32)
    h = x
    for l in range(DEPTH):
        h = hybrid_layer(h, c_act, pos, norm_w[l], ada_w[l], ada_b[l], w_in[l], ret_gn_w[l],
                         attn_sinks[l], w_ret_o[l], w_swa_o[l], w_out[l])
    return rms_norm(h, final_norm_w)
```

```cpp
#include <hip/hip_runtime.h>
#include <hip/hip_cooperative_groups.h>
#include <cstdio>
#include <cstdint>
namespace cg = cooperative_groups;

#define LAS __attribute__((address_space(3)))
typedef _Float16 half_t;
typedef _Float16 h8 __attribute__((ext_vector_type(8)));
typedef _Float16 h4 __attribute__((ext_vector_type(4)));
typedef short s4v __attribute__((ext_vector_type(4)));
typedef float f32x4 __attribute__((ext_vector_type(4)));
typedef short s8v __attribute__((ext_vector_type(8)));
constexpr bool INPROJ_BF16 = true;
constexpr bool TAIL_BF16 = true;
__device__ __forceinline__ half_t op16(float f, bool bf) { return bf ? __builtin_bit_cast(half_t, (__bf16)f) : (half_t)f; }

constexpr int SEQ = 4096, NTOK = 8192, DM = 2048, NIN = 15360, DEPTH = 4;
constexpr int C_RQ = 0, C_RK = 1024, C_RV = 2048, C_RG = 4096, C_SQ = 6144, C_SK = 8192, C_SV = 8704, C_SG = 9216, C_MR = 11264, C_MS = 13312;
constexpr float EPS = 1e-6f;
constexpr size_t SZ_WIN = (size_t)NIN * DM * 2, SZ_WMRG = (size_t)DM * 4096 * 2, SZ_WOUT = (size_t)DM * DM * 2;
constexpr size_t WS_WIN = 0;
constexpr size_t WS_WMRG = WS_WIN + DEPTH * SZ_WIN;
constexpr size_t WS_WOUT = WS_WMRG + DEPTH * SZ_WMRG;
constexpr size_t WS_MOD = WS_WOUT + DEPTH * SZ_WOUT;
constexpr size_t WS_ROT = WS_MOD + (size_t)DEPTH * 2 * 6144 * 4;
constexpr size_t WS_U = WS_ROT + (size_t)2 * SEQ * 64 * 4;
constexpr size_t WS_PROJ = WS_U + (size_t)NTOK * DM * 2;
constexpr size_t WS_RA = WS_PROJ + (size_t)NTOK * NIN * 2;
constexpr size_t WS_MRG = WS_RA + (size_t)NTOK * 4096 * 2;
constexpr size_t WS_H = WS_MRG + (size_t)NTOK * DM * 2;
constexpr size_t WS_KV = WS_H + (size_t)NTOK * DM * 4;
constexpr size_t WS_ST = WS_KV + (size_t)512 * 32768 * 4;
constexpr size_t WS_BAR = WS_ST + (size_t)512 * 32768 * 2;
constexpr size_t WS_END = WS_BAR + 16384;
constexpr int LDS_BYTES = 131072 + 256;

struct Params {
    const float *x, *c, *norm_w, *ada_w, *ada_b, *w_in, *gn_w, *sinks, *w_ret_o, *w_swa_o, *w_out, *fnorm_w;
    float* out; unsigned char* ws;
};

namespace pg8 {
constexpr int BM = 256, BK = 64, HALF = 128, HTB = HALF * BK * 2, STAGE_BYTES = 8 * HTB, NXCD = 8, WGM = 8;
__host__ __device__ __forceinline__ int lds_byte(int r, int c) { const int st = (r >> 4) * 2 + (c >> 5), rr = r & 15, cc = c & 31, ob = rr * 64 + cc * 2; return st * 1024 + (ob ^ (((ob >> 9) & 1) << 5)); }
__host__ __device__ __forceinline__ void stage_rc(int b, int& R, int& C) { const int st = b / 1024, sb = b % 1024, swz = sb ^ (((sb >> 9) & 1) << 5); R = (st >> 1) * 16 + swz / 64; C = (st & 1) * 32 + (swz % 64) / 2; }
__host__ __device__ __forceinline__ int perm32(int rho) { const int n = rho >> 4, i = rho & 15; return 8 * (i >> 2) + 4 * n + (i & 3); }

struct Unit { int pm, pn; };
struct Gemm { const half_t* A; const half_t* Bt; int M, N, K; };

struct StaticOrder {
    int nM, nN, nwg, G, c;
    __device__ void init(int M, int N, int G_, int c_) { nM = M / BM; nN = N / BM; nwg = nM * nN; G = G_; c = c_; }
    __device__ bool next(int i, Unit& u) const {
        const long L = (long)i * G + c; if (L >= nwg) return false;
        int wgid = (int)L; { const int q = nwg / NXCD, r = nwg % NXCD, xcd = wgid % NXCD, off = wgid / NXCD; wgid = (xcd < r ? xcd * (q + 1) : r * (q + 1) + (xcd - r) * q) + off; }
        const int nig = WGM * nN, gid = wgid / nig, fm = gid * WGM, gsz = (nM - fm) < WGM ? (nM - fm) : WGM;
        u.pm = fm + ((wgid % nig) % gsz); u.pn = (wgid % nig) / gsz; return true;
    }
};

template <class Epi>
__device__ __forceinline__ void gemm_phase(LAS unsigned char* lds, const Gemm g, const StaticOrder& S, const Epi& E, const int tid) {
    const int wid = __builtin_amdgcn_readfirstlane(tid >> 6), lane = tid & 63, wr = wid >> 2, wc = wid & 3, fr = lane & 15, fq = lane >> 4;
    const int K = g.K, nt = K / BK;
    unsigned voffA[2], voffB[2];
#pragma unroll
    for (int i = 0; i < 2; ++i) { int R, C; stage_rc(tid * 16 + i * 8192, R, C); const int Rb = Epi::BJ_ADJ ? ((R >> 5) * 64 + perm32(R & 31)) : (Epi::PERM ? ((R & ~31) + perm32(R & 31)) : R);
        voffA[i] = (unsigned)(R * K + C) * 2u; voffB[i] = (unsigned)(Rb * K + C) * 2u; }
    const size_t kstep = (size_t)(BK * 2);
    const size_t hstep = (size_t)HALF * K * 2;
    const size_t tstep = 2 * hstep;
    const size_t hstepB = Epi::BJ_ADJ ? (size_t)32 * K * 2 : hstep;
    const unsigned ldsw = (unsigned)wid * 1024u;
    const int aoff = lds_byte(wr * 64 + fr, fq * 8), boff = lds_byte(wc * 32 + fr, fq * 8);
#define PG8_SA(b, h) (((b) * 2 + (h)) * HTB)
#define PG8_SB(b, h) ((4 + (b) * 2 + (h)) * HTB)
#define PG8_STAGE(bufoff, gbase, voff) do { _Pragma("unroll") for (int _i = 0; _i < 2; ++_i) \
        __builtin_amdgcn_global_load_lds((const unsigned*)((const char*)(gbase) + (voff)[_i]), (LAS unsigned*)(lds + (bufoff) + ldsw + _i * 8192), 16, 0, 0); } while (0)
#define PG8_LDA(dst, b, h) do { _Pragma("unroll") for (int m = 0; m < 4; ++m) _Pragma("unroll") for (int k = 0; k < 2; ++k) dst[m][k] = *(const LAS h8*)(lds + PG8_SA(b, h) + aoff + m * 2048 + k * 1024); } while (0)
#define PG8_LDB(dst, b, h) do { _Pragma("unroll") for (int n = 0; n < 2; ++n) _Pragma("unroll") for (int k = 0; k < 2; ++k) dst[n][k] = *(const LAS h8*)(lds + PG8_SB(b, h) + boff + n * 2048 + k * 1024); } while (0)
#define PG8_MMA(ai, bj, At, Bt) do { __builtin_amdgcn_s_setprio(1); _Pragma("unroll") for (int m = 0; m < 4; ++m) _Pragma("unroll") for (int n = 0; n < 2; ++n) _Pragma("unroll") for (int k = 0; k < 2; ++k) \
        { if constexpr (Epi::BF16) acc[ai][bj][m][n] = __builtin_amdgcn_mfma_f32_16x16x32_bf16(__builtin_bit_cast(s8v, Bt[n][k]), __builtin_bit_cast(s8v, At[m][k]), acc[ai][bj][m][n], 0, 0, 0); \
          else acc[ai][bj][m][n] = __builtin_amdgcn_mfma_f32_16x16x32_f16(Bt[n][k], At[m][k], acc[ai][bj][m][n], 0, 0, 0); } __builtin_amdgcn_s_setprio(0); } while (0)
#define PG8_WAIT_V(n) asm volatile("s_waitcnt vmcnt(" #n ")" ::: "memory")
#define PG8_WAIT_L(n) asm volatile("s_waitcnt lgkmcnt(" #n ")" ::: "memory")
#define PG8_BAR __builtin_amdgcn_s_barrier()
#define PG8_SCHED __builtin_amdgcn_sched_barrier(0)
    Unit cur, nxt; int ui = 0;
    if (!S.next(0, cur)) return;
    f32x4 acc[2][2][4][2];
#pragma unroll
    for (int a = 0; a < 2; ++a)
#pragma unroll
        for (int b = 0; b < 2; ++b)
#pragma unroll
            for (int m = 0; m < 4; ++m)
#pragma unroll
                for (int n = 0; n < 2; ++n) acc[a][b][m][n] = (f32x4){0.f, 0.f, 0.f, 0.f};
    h8 At[4][2], B0[2][2], B1[2][2];
    const char* cA = (const char*)g.A + (size_t)cur.pm * tstep; const char* cB = (const char*)g.Bt + (size_t)cur.pn * tstep;
    PG8_STAGE(PG8_SB(0, 0), cB, voffB); PG8_STAGE(PG8_SA(0, 0), cA, voffA); PG8_STAGE(PG8_SB(0, 1), cB + hstepB, voffB); PG8_STAGE(PG8_SA(0, 1), cA + hstep, voffA);
    if (wr == 1) PG8_BAR;
    PG8_WAIT_V(4); PG8_BAR;
    PG8_STAGE(PG8_SB(1, 0), cB + kstep, voffB); PG8_STAGE(PG8_SA(1, 0), cA + kstep, voffA); PG8_STAGE(PG8_SB(1, 1), cB + hstepB + kstep, voffB);
    PG8_WAIT_V(6); PG8_BAR;
    for (;;) {
        const bool has_next = S.next(ui + 1, nxt);
        const char* nA = has_next ? (const char*)g.A + (size_t)nxt.pm * tstep : cA; const char* nB = has_next ? (const char*)g.Bt + (size_t)nxt.pn * tstep : cB;
        for (int t = 0; t < nt; t += 2) {
            const bool last = (t == nt - 2);
            const char* a1 = cA + (size_t)(t + 1) * kstep;
            const char* a2 = last ? nA : cA + (size_t)(t + 2) * kstep; const char* b2 = last ? nB : cB + (size_t)(t + 2) * kstep;
            const char* a3 = a2 + kstep; const char* b3 = b2 + kstep;
            if constexpr (Epi::HAS_MID) { if (t == (nt >> 1)) E.mid(acc, cur, wr, wc, fr, fq); }
            PG8_LDB(B0, 0, 0); PG8_SCHED; PG8_LDA(At, 0, 0); PG8_STAGE(PG8_SA(1, 1), a1 + hstep, voffA);
            PG8_WAIT_L(8); PG8_BAR; PG8_WAIT_L(0); PG8_MMA(0, 0, At, B0); PG8_BAR; PG8_SCHED;
            PG8_LDB(B1, 0, 1); PG8_STAGE(PG8_SB(0, 0), b2, voffB);
            PG8_BAR; PG8_WAIT_L(0); PG8_MMA(0, 1, At, B1); PG8_BAR;
            PG8_LDA(At, 0, 1); PG8_STAGE(PG8_SA(0, 0), a2, voffA);
            PG8_BAR; PG8_WAIT_L(0); PG8_MMA(1, 0, At, B0); PG8_BAR; PG8_SCHED;
            PG8_STAGE(PG8_SB(0, 1), b2 + hstepB, voffB);
            PG8_WAIT_V(6); PG8_BAR; PG8_MMA(1, 1, At, B1); PG8_BAR;
            PG8_LDB(B0, 1, 0); PG8_SCHED; PG8_LDA(At, 1, 0); PG8_STAGE(PG8_SA(0, 1), a2 + hstep, voffA);
            PG8_WAIT_L(8); PG8_BAR; PG8_WAIT_L(0); PG8_MMA(0, 0, At, B0); PG8_BAR; PG8_SCHED;
            PG8_LDB(B1, 1, 1); PG8_STAGE(PG8_SB(1, 0), b3, voffB);
            PG8_BAR; PG8_WAIT_L(0); PG8_MMA(0, 1, At, B1); PG8_BAR;
            PG8_LDA(At, 1, 1); PG8_STAGE(PG8_SA(1, 0), a3, voffA);
            PG8_BAR; PG8_WAIT_L(0); PG8_MMA(1, 0, At, B0); PG8_BAR; PG8_SCHED;
            PG8_STAGE(PG8_SB(1, 1), b3 + hstepB, voffB);
            PG8_WAIT_V(6); PG8_BAR; PG8_MMA(1, 1, At, B1); PG8_BAR;
        }
        E(acc, cur, wr, wc, fr, fq);
        if (!has_next) break;
#pragma unroll
        for (int a = 0; a < 2; ++a)
#pragma unroll
            for (int b = 0; b < 2; ++b)
#pragma unroll
                for (int m = 0; m < 4; ++m)
#pragma unroll
                    for (int n = 0; n < 2; ++n) acc[a][b][m][n] = (f32x4){0.f, 0.f, 0.f, 0.f};
        cur = nxt; cA = nA; cB = nB; ++ui;
    }
    PG8_WAIT_V(0);
    if (wr == 0) PG8_BAR;
    PG8_BAR;
#undef PG8_SA
#undef PG8_SB
#undef PG8_STAGE
#undef PG8_LDA
#undef PG8_LDB
#undef PG8_MMA
#undef PG8_WAIT_V
#undef PG8_WAIT_L
#undef PG8_BAR
#undef PG8_SCHED
}
}

__device__ __forceinline__ float shx(float v, int lane, int m) { return __builtin_bit_cast(float, __builtin_amdgcn_ds_bpermute((lane ^ m) << 2, __builtin_bit_cast(int, v))); }
__device__ __forceinline__ float wave_sum(float v, int lane) {
#pragma unroll
    for (int o = 1; o < 64; o <<= 1) v += shx(v, lane, o);
    return v;
}
__device__ __forceinline__ float ex2(float x) { return __builtin_amdgcn_exp2f(x); }
__device__ __forceinline__ float siluf(float x) { return x * __builtin_amdgcn_rcpf(1.f + ex2(x * -1.44269504f)); }
__device__ __forceinline__ h4 tr_read(const LAS half_t* p) { s4v r = __builtin_amdgcn_ds_read_tr16_b64_v4i16((LAS s4v*)p); return __builtin_bit_cast(h4, r); }
__device__ __forceinline__ h8 cat8(h4 a, h4 b) { h8 r; r[0] = a[0]; r[1] = a[1]; r[2] = a[2]; r[3] = a[3]; r[4] = b[0]; r[5] = b[1]; r[6] = b[2]; r[7] = b[3]; return r; }
__device__ __forceinline__ float ret_logg(int h) { return log1pf(-exp2f(-5.f - (float)h)); }

struct EpiProj {
    static constexpr bool PERM = true, HAS_MID = false, BJ_ADJ = true, BF16 = INPROJ_BF16;
    half_t* O;
    typedef int i32x4 __attribute__((ext_vector_type(4)));
    __device__ __forceinline__ void mid(f32x4 (&)[2][2][4][2], const pg8::Unit&, int, int, int, int) const {}
    static __device__ __forceinline__ h8 pack8(const f32x4 v0, const f32x4 v1) { h8 o; o[0] = (half_t)v0[0]; o[1] = (half_t)v0[1]; o[2] = (half_t)v0[2]; o[3] = (half_t)v0[3]; o[4] = (half_t)v1[0]; o[5] = (half_t)v1[1]; o[6] = (half_t)v1[2]; o[7] = (half_t)v1[3]; return o; }
    __device__ __forceinline__ void operator()(f32x4 (&acc)[2][2][4][2], const pg8::Unit& u, int wr, int wc, int fr, int fq) const {
        const bool hi = fr >= 8;
        const int row0 = u.pm * 256 + wr * 64 + (fr & 7), col = u.pn * 256 + wc * 64 + fq * 8 + (hi ? 32 : 0);
#pragma unroll
        for (int ai = 0; ai < 2; ++ai)
#pragma unroll
            for (int m = 0; m < 4; ++m) {
                const h8 x0 = pack8(acc[ai][0][m][0], acc[ai][0][m][1]), x1 = pack8(acc[ai][1][m][0], acc[ai][1][m][1]);
                const i32x4 snd = hi ? __builtin_bit_cast(i32x4, x0) : __builtin_bit_cast(i32x4, x1);
                i32x4 rcv;
#pragma unroll
                for (int d = 0; d < 4; ++d) rcv[d] = __builtin_amdgcn_update_dpp(0, snd[d], 0x128  , 0xF, 0xF, false);
                const h8 rv = __builtin_bit_cast(h8, rcv);
                const h8 vA = hi ? rv : x0;
                const h8 vB = hi ? x1 : rv;
                half_t* rowp = O + (size_t)(row0 + ai * 128 + m * 16) * NIN + col;
                __builtin_nontemporal_store(vA, (h8*)rowp); __builtin_nontemporal_store(vB, (h8*)(rowp + (size_t)8 * NIN)); }
    }
};
struct EpiMerge {
    static constexpr bool PERM = true, HAS_MID = true, BJ_ADJ = false, BF16 = TAIL_BF16;
    const half_t* P; half_t* O;
    __device__ __forceinline__ void mid(f32x4 (&acc)[2][2][4][2], const pg8::Unit& u, int wr, int wc, int fr, int fq) const {
        const int row0 = u.pm * 256 + wr * 64 + fr, col0 = u.pn * 256 + wc * 32 + 8 * fq;
        unsigned base = (unsigned)(row0 * NIN + col0);
        asm volatile("" : "+v"(base));
        const half_t* bp0 = P + base;
#pragma unroll
        for (int ai = 0; ai < 2; ++ai)
#pragma unroll
            for (int m = 0; m < 4; ++m) { const half_t* rowp = bp0 + (size_t)(ai * 128 + m * 16) * NIN;
                __builtin_amdgcn_sched_barrier(0);
#pragma unroll
                for (int bj = 0; bj < 2; ++bj) { const h8 ga = __builtin_nontemporal_load((const h8*)(rowp + C_MR + bj * 128)), gb = __builtin_nontemporal_load((const h8*)(rowp + C_MS + bj * 128));
#pragma unroll
                    for (int n = 0; n < 2; ++n)
#pragma unroll
                        for (int i = 0; i < 4; ++i) { const float a = (float)ga[4 * n + i], b = (float)gb[4 * n + i];
                            acc[ai][bj][m][n][i] *= (1.f + ex2(b * -1.44269504f)) * __builtin_amdgcn_rcpf(1.f + ex2(a * -1.44269504f)); } } }
    }
    __device__ __forceinline__ void operator()(const f32x4 (&acc)[2][2][4][2], const pg8::Unit& u, int wr, int wc, int fr, int fq) const {
        const int row0 = u.pm * 256 + wr * 64 + fr, col0 = u.pn * 256 + wc * 32 + 8 * fq;
#pragma unroll
        for (int ai = 0; ai < 2; ++ai)
#pragma unroll
            for (int m = 0; m < 4; ++m) { const size_t row = (size_t)(row0 + ai * 128 + m * 16);
#pragma unroll
                for (int bj = 0; bj < 2; ++bj) { const h8 gb = __builtin_nontemporal_load((const h8*)(P + row * NIN + col0 + C_MS + bj * 128));
                    h8 o;
#pragma unroll
                    for (int n = 0; n < 2; ++n)
#pragma unroll
                        for (int i = 0; i < 4; ++i) o[4 * n + i] = op16(acc[ai][bj][m][n][i] * __builtin_amdgcn_rcpf(1.f + ex2((float)gb[4 * n + i] * -1.44269504f)), TAIL_BF16);
                    *(h8*)(O + row * DM + col0 + bj * 128) = o; } }
    }
};
template <bool XF32>
struct EpiOut {
    static constexpr bool PERM = true, HAS_MID = false, BJ_ADJ = false, BF16 = TAIL_BF16;
    const float* xin; const float* gate; half_t* H;
    __device__ __forceinline__ void mid(f32x4 (&)[2][2][4][2], const pg8::Unit&, int, int, int, int) const {}
    __device__ __forceinline__ void operator()(const f32x4 (&acc)[2][2][4][2], const pg8::Unit& u, int wr, int wc, int fr, int fq) const {
        const int row0 = u.pm * 256 + wr * 64 + fr, col0 = u.pn * 256 + wc * 32 + 8 * fq;
        const float* gp = gate + (size_t)((u.pm * 256) >> 12) * 6144 + col0;
        f32x4 gv[2][2];
#pragma unroll
        for (int bj = 0; bj < 2; ++bj)
#pragma unroll
            for (int n = 0; n < 2; ++n) gv[bj][n] = *(const f32x4*)(gp + bj * 128 + 4 * n);
#pragma unroll
        for (int ai = 0; ai < 2; ++ai)
#pragma unroll
            for (int m = 0; m < 4; ++m) { const size_t ro = (size_t)(row0 + ai * 128 + m * 16) * DM + col0;
#pragma unroll
                for (int bj = 0; bj < 2; ++bj) {
                    f32x4 x0, x1;
                    if (XF32) { x0 = *(const f32x4*)(xin + ro + bj * 128); x1 = *(const f32x4*)(xin + ro + bj * 128 + 4); }
                    else { const h8 xh = *(const h8*)(H + ro + bj * 128); x0 = (f32x4){(float)xh[0], (float)xh[1], (float)xh[2], (float)xh[3]}; x1 = (f32x4){(float)xh[4], (float)xh[5], (float)xh[6], (float)xh[7]}; }
                    const f32x4 y0 = x0 + gv[bj][0] * acc[ai][bj][m][0], y1 = x1 + gv[bj][1] * acc[ai][bj][m][1];
                    h8 o; o[0] = (half_t)y0[0]; o[1] = (half_t)y0[1]; o[2] = (half_t)y0[2]; o[3] = (half_t)y0[3]; o[4] = (half_t)y1[0]; o[5] = (half_t)y1[1]; o[6] = (half_t)y1[2]; o[7] = (half_t)y1[3];
                    *(h8*)(H + ro + bj * 128) = o; } }
    }
};

constexpr int I_IN = 64 * (NIN / 64), I_SQ = 64 * (DM / 64), I_SMALL = 3 * I_SQ;
struct TItem { const float* src; half_t* dst; int N, ldt; bool bf; };
__device__ __forceinline__ TItem titem(const Params& p, int l, int r, int lane) {
    const float* W; half_t* WT; int N, ldt, koff = 0;
    unsigned char* ws = p.ws;
    const bool bf = (r < I_IN) ? INPROJ_BF16 : TAIL_BF16;
    if (r < I_IN) { W = p.w_in + (size_t)l * DM * NIN; N = NIN; WT = (half_t*)(ws + WS_WIN + l * SZ_WIN); ldt = DM; }
    else { r -= I_IN; N = DM;
        if (r < I_SQ) { W = p.w_ret_o + (size_t)l * DM * DM; WT = (half_t*)(ws + WS_WMRG + l * SZ_WMRG); ldt = 4096; }
        else if (r < 2 * I_SQ) { r -= I_SQ; W = p.w_swa_o + (size_t)l * DM * DM; WT = (half_t*)(ws + WS_WMRG + l * SZ_WMRG); ldt = 4096; koff = 2048; }
        else { r -= 2 * I_SQ; W = p.w_out + (size_t)l * DM * DM; WT = (half_t*)(ws + WS_WOUT + l * SZ_WOUT); ldt = DM; } }
    const int nblk = N >> 6, kb = r / nblk, nb = r - kb * nblk, k0 = kb * 32, n0 = nb * 64;
    TItem t; t.N = N; t.ldt = ldt; t.bf = bf;
    t.src = W + (size_t)(k0 + (lane >> 4)) * N + n0 + (lane & 15) * 4;
    t.dst = WT + (size_t)(n0 + (lane >> 2)) * ldt + koff + k0 + 8 * (lane & 3);
    return t;
}
__device__ __forceinline__ void tload(const TItem& t, f32x4 (&v)[8]) {
#pragma unroll
    for (int i = 0; i < 8; ++i) v[i] = *(const f32x4*)(t.src + (size_t)(4 * i) * t.N);
}
__device__ __forceinline__ void tstore(const TItem& t, const f32x4 (&v)[8], LAS float* scr, int lane) {
    const int rr = lane >> 4, c4 = (lane & 15) * 4;
#pragma unroll
    for (int i = 0; i < 8; ++i) *(LAS f32x4*)(scr + (4 * i + rr) * 68 + c4) = v[i];
    asm volatile("s_waitcnt lgkmcnt(0)" ::: "memory");
    const int c = lane & 3;
#pragma unroll
    for (int j = 0; j < 4; ++j) { const int n = (lane >> 2) + 16 * j; const LAS float* s = scr + (8 * c) * 68 + n;
        h8 o;
#pragma unroll
        for (int e = 0; e < 8; ++e) o[e] = op16(s[e * 68], t.bf);
        *(h8*)(t.dst + (size_t)(16 * j) * t.ldt) = o; }
    asm volatile("s_waitcnt lgkmcnt(0)" ::: "memory");
}
__device__ __forceinline__ void convert_range(const Params& p, int l, int lo, int hi, LAS float* scr, int gw, int NGW, int lane) {
    int it = lo + gw;
    if (it >= hi) return;
    f32x4 cur[8], nxt[8];
    TItem tc = titem(p, l, it, lane);
    tload(tc, cur);
    for (;;) {
        const int itn = it + NGW; const bool more = itn < hi;
        TItem tn = tc;
        if (more) { tn = titem(p, l, itn, lane); tload(tn, nxt); }
        tstore(tc, cur, scr, lane);
        if (!more) break;
#pragma unroll
        for (int i = 0; i < 8; ++i) cur[i] = nxt[i];
        tc = tn; it = itn;
    }
}

__device__ __forceinline__ void phase_prep(const Params& p, LAS unsigned char* lds, int tid, int wave, int lane, int G) {
    unsigned char* ws = p.ws;
    float* mod = (float*)(ws + WS_MOD);
    for (int item = blockIdx.x; item < DEPTH * 24; item += G) {
        LAS float* cact = (LAS float*)lds; LAS float* red = (LAS float*)(lds + 16384);
        __syncthreads();
        for (int i = tid; i < 4096; i += 512) { const float cv = p.c[i]; cact[i] = cv / (1.f + expf(-cv)); }
        __syncthreads();
        const int l = item / 24, cgi = item - l * 24;
        const float* W = p.ada_w + (size_t)l * DM * 6144 + cgi * 256 + lane * 4;
        f32x4 a0 = {0.f, 0.f, 0.f, 0.f}, a1 = {0.f, 0.f, 0.f, 0.f};
        const int kb = wave * 256;
        for (int k = kb; k < kb + 256; k += 8) {
            f32x4 w[8];
#pragma unroll
            for (int i = 0; i < 8; ++i) w[i] = *(const f32x4*)(W + (size_t)(k + i) * 6144);
#pragma unroll
            for (int i = 0; i < 8; ++i) { a0 += w[i] * cact[k + i]; a1 += w[i] * cact[2048 + k + i]; }
        }
        *(LAS f32x4*)(red + (wave * 2 + 0) * 256 + lane * 4) = a0;
        *(LAS f32x4*)(red + (wave * 2 + 1) * 256 + lane * 4) = a1;
        __syncthreads();
        { const int b = tid >> 8, col = tid & 255; float s = p.ada_b[l * 6144 + cgi * 256 + col];
#pragma unroll
          for (int w = 0; w < 8; ++w) s += red[(w * 2 + b) * 256 + col];
          mod[(size_t)(l * 2 + b) * 6144 + cgi * 256 + col] = s; }
    }
    __syncthreads();
    { float* rot = (float*)(ws + WS_ROT);
      for (int idx = blockIdx.x * 512 + tid; idx < SEQ * 64; idx += G * 512) { const int pos = idx >> 6, j = idx & 63;
          const float inv = 1.0f / powf(10000.f, (float)j / 63.0f); const float ang = (float)pos * inv;
          rot[idx] = cosf(ang); rot[SEQ * 64 + idx] = sinf(ang); } }
    { LAS float* scr = (LAS float*)(lds + 32768 + wave * 8704);
      const int nb = (DEPTH * 24 < G) ? DEPTH * 24 : 0;
      if ((int)blockIdx.x >= nb) { const int gwa = ((int)blockIdx.x - nb) * 8 + wave, NGA = (G - nb) * 8;
          convert_range(p, 0, 0, I_IN + I_SMALL, scr, gwa, NGA, lane);
          convert_range(p, 1, I_IN, I_IN + I_SMALL, scr, gwa, NGA, lane); }
      const int gw = blockIdx.x * 8 + wave, NGW = G * 8;
      convert_range(p, 2, I_IN, I_IN + I_SMALL, scr, gw, NGW, lane);
      convert_range(p, 3, I_IN, I_IN + I_SMALL, scr, gw, NGW, lane);
      if (G != 256) for (int l = 1; l < DEPTH; ++l) convert_range(p, l, 0, I_IN, scr, gw, NGW, lane); }
}

__device__ __forceinline__ void phase_u(const Params& p, int l, const float* xin, int wave, int lane, int G) {
    half_t* U = (half_t*)(p.ws + WS_U); const float* mod = (const float*)(p.ws + WS_MOD);
    const int gw = blockIdx.x * 8 + wave, NGW = G * 8;
    for (int row = gw; row < NTOK; row += NGW) {
        const f32x4* xr = (const f32x4*)(xin + (size_t)row * DM) + lane;
        f32x4 v[8]; float ss = 0.f;
#pragma unroll
        for (int j = 0; j < 8; ++j) { v[j] = xr[64 * j]; ss += (v[j][0] * v[j][0] + v[j][1] * v[j][1]) + (v[j][2] * v[j][2] + v[j][3] * v[j][3]); }
        ss = wave_sum(ss, lane);
        const float rinv = 1.0f / sqrtf(ss * (1.f / DM) + EPS);
        const float* mb = mod + (size_t)(l * 2 + (row >> 12)) * 6144;
#pragma unroll
        for (int j = 0; j < 8; ++j) { const int col = 4 * lane + 256 * j;
            const f32x4 nw = *(const f32x4*)(p.norm_w + l * DM + col), sh = *(const f32x4*)(mb + col), sc = *(const f32x4*)(mb + 2048 + col);
            const f32x4 uu = (v[j] * rinv) * nw * (sc + 1.f) + sh;
            h4 o; o[0] = op16(uu[0], INPROJ_BF16); o[1] = op16(uu[1], INPROJ_BF16); o[2] = op16(uu[2], INPROJ_BF16); o[3] = op16(uu[3], INPROJ_BF16);
            *(h4*)(U + (size_t)row * DM + col) = o; }
    }
}
__device__ __forceinline__ float load_hrow(const half_t* hrow, int lane, f32x4 (&v)[8]) {
    float ss = 0.f;
#pragma unroll
    for (int j = 0; j < 4; ++j) { const h8 x = *(const h8*)(hrow + 8 * lane + 512 * j);
        v[2 * j] = (f32x4){(float)x[0], (float)x[1], (float)x[2], (float)x[3]}; v[2 * j + 1] = (f32x4){(float)x[4], (float)x[5], (float)x[6], (float)x[7]};
        ss += (v[2 * j][0] * v[2 * j][0] + v[2 * j][1] * v[2 * j][1]) + (v[2 * j][2] * v[2 * j][2] + v[2 * j][3] * v[2 * j][3]);
        ss += (v[2 * j + 1][0] * v[2 * j + 1][0] + v[2 * j + 1][1] * v[2 * j + 1][1]) + (v[2 * j + 1][2] * v[2 * j + 1][2] + v[2 * j + 1][3] * v[2 * j + 1][3]); }
    return ss;
}
__device__ __forceinline__ void phase_u_h(const Params& p, int l, int wave, int lane, int G) {
    half_t* U = (half_t*)(p.ws + WS_U); const float* mod = (const float*)(p.ws + WS_MOD); const half_t* Hh = (const half_t*)(p.ws + WS_H);
    const int gw = blockIdx.x * 8 + wave, NGW = G * 8;
    for (int row = gw; row < NTOK; row += NGW) {
        f32x4 v[8];
        const float ss = wave_sum(load_hrow(Hh + (size_t)row * DM, lane, v), lane);
        const float rinv = 1.0f / sqrtf(ss * (1.f / DM) + EPS);
        const float* mb = mod + (size_t)(l * 2 + (row >> 12)) * 6144;
#pragma unroll
        for (int j = 0; j < 4; ++j) { const int col = 8 * lane + 512 * j;
            h8 o;
#pragma unroll
            for (int hh = 0; hh < 2; ++hh) { const int c = col + 4 * hh;
                const f32x4 nw = *(const f32x4*)(p.norm_w + l * DM + c), sh = *(const f32x4*)(mb + c), sc = *(const f32x4*)(mb + 2048 + c);
                const f32x4 uu = (v[2 * j + hh] * rinv) * nw * (sc + 1.f) + sh;
                o[4 * hh] = op16(uu[0], INPROJ_BF16); o[4 * hh + 1] = op16(uu[1], INPROJ_BF16); o[4 * hh + 2] = op16(uu[2], INPROJ_BF16); o[4 * hh + 3] = op16(uu[3], INPROJ_BF16); }
            *(h8*)(U + (size_t)row * DM + col) = o; }
    }
}
__device__ __forceinline__ void phase_final(const Params& p, int wave, int lane, int G) {
    const half_t* Hh = (const half_t*)(p.ws + WS_H);
    const int gw = blockIdx.x * 8 + wave, NGW = G * 8;
    for (int row = gw; row < NTOK; row += NGW) {
        f32x4 v[8];
        const float ss = wave_sum(load_hrow(Hh + (size_t)row * DM, lane, v), lane);
        const float rinv = 1.0f / sqrtf(ss * (1.f / DM) + EPS);
#pragma unroll
        for (int j = 0; j < 4; ++j)
#pragma unroll
            for (int hh = 0; hh < 2; ++hh) { const int c = 8 * lane + 512 * j + 4 * hh;
                const f32x4 nw = *(const f32x4*)(p.fnorm_w + c);
                *(f32x4*)(p.out + (size_t)row * DM + c) = (v[2 * j + hh] * rinv) * nw; }
    }
}

constexpr int KSTR = 136, VSTR = 272;
constexpr int RV_OFF = 128 * KSTR * 2;
template <bool ZETA>
__device__ __forceinline__ void ret_stage(const Params& p, LAS unsigned char* lds, int tb, int h, int c, float logg, int tid) {
    const half_t* PR = (const half_t*)(p.ws + WS_PROJ); const float* rot = (const float*)(p.ws + WS_ROT);
    LAS half_t* Ks = (LAS half_t*)lds; LAS half_t* Vs = (LAS half_t*)(lds + RV_OFF);
#pragma unroll
    for (int i = 0; i < 2; ++i) { const int id = tid + 512 * i, pos = id >> 3, ch = id & 7;
        const half_t* src = PR + (size_t)(tb + pos) * NIN + C_RK + h * 128 + ch * 8;
        const h8 x1 = *(const h8*)src, x2 = *(const h8*)(src + 64);
        const float* cp = rot + (size_t)(c * 128 + pos) * 64 + ch * 8; const float* sp = cp + SEQ * 64;
        const f32x4 c0 = *(const f32x4*)cp, c1 = *(const f32x4*)(cp + 4), s0 = *(const f32x4*)sp, s1 = *(const f32x4*)(sp + 4);
        float sc = 0.08838834764831845f; if (ZETA) sc *= __expf(logg * (float)(127 - pos));
        h8 y1, y2;
#pragma unroll
        for (int e = 0; e < 8; ++e) { const float co = e < 4 ? c0[e & 3] : c1[e & 3], si = e < 4 ? s0[e & 3] : s1[e & 3]; const float a = (float)x1[e], b = (float)x2[e];
            y1[e] = (half_t)((a * co - b * si) * sc); y2[e] = (half_t)((b * co + a * si) * sc); }
        *(LAS h8*)(Ks + pos * KSTR + ch * 8) = y1; *(LAS h8*)(Ks + pos * KSTR + 64 + ch * 8) = y2; }
#pragma unroll
    for (int i = 0; i < 8; ++i) { const int id = tid + 512 * i, pos = id >> 5, ch = id & 31;
        *(LAS h8*)(Vs + pos * VSTR + ch * 8) = *(const h8*)(PR + (size_t)(tb + pos) * NIN + C_RV + h * 256 + ch * 8); }
}

__device__ __forceinline__ void ret_kv_item(const Params& p, LAS unsigned char* lds, int item, int tid, int wave, int lane) {
    const int b = item >> 8, h = (item >> 5) & 7, c = item & 31, tb = b * SEQ + c * 128;
    const float logg = ret_logg(h);
    ret_stage<true>(p, lds, tb, h, c, logg, tid);
    __syncthreads();
    const LAS half_t* Ks = (const LAS half_t*)lds; const LAS half_t* Vs = (const LAS half_t*)(lds + RV_OFF);
    const int g = lane >> 4, r = lane & 15, q = (lane & 15) >> 2, pp = lane & 3;
    h8 a[4];
#pragma unroll
    for (int ks = 0; ks < 4; ++ks) { const LAS half_t* ap = Ks + (ks * 32 + g * 8 + q) * KSTR + wave * 16 + 4 * pp; a[ks] = cat8(tr_read(ap), tr_read(ap + 4 * KSTR)); }
    half_t* KV = (half_t*)(p.ws + WS_KV) + (size_t)item * 32768;
#pragma unroll 4
    for (int dvt = 0; dvt < 16; ++dvt) {
        f32x4 acc = {0.f, 0.f, 0.f, 0.f};
#pragma unroll
        for (int ks = 0; ks < 4; ++ks) { const LAS half_t* bp = Vs + (ks * 32 + g * 8 + q) * VSTR + dvt * 16 + 4 * pp; const h8 bf = cat8(tr_read(bp), tr_read(bp + 4 * VSTR));
            acc = __builtin_amdgcn_mfma_f32_16x16x32_f16(a[ks], bf, acc, 0, 0, 0); }
        h4 kvh; kvh[0] = (half_t)acc[0]; kvh[1] = (half_t)acc[1]; kvh[2] = (half_t)acc[2]; kvh[3] = (half_t)acc[3];
        *(h4*)(KV + (size_t)(((dvt * 4 + (wave >> 1)) * 64 + (((wave & 1) * 2 + (g >> 1)) * 16 + r)) * 8 + 4 * (g & 1))) = kvh;
    }
    __syncthreads();
}

__device__ __forceinline__ void phase_scan(const Params& p, int tid, int G) {
    const h4* KV = (const h4*)(p.ws + WS_KV); h4* ST = (h4*)(p.ws + WS_ST);
    for (int e4 = blockIdx.x * 512 + tid; e4 < 16 * 8192; e4 += G * 512) {
        const int bh = e4 >> 13, off = e4 & 8191; const float gch = __expf(ret_logg(bh & 7) * 128.f);
        f32x4 s = {0.f, 0.f, 0.f, 0.f};
#pragma unroll 8
        for (int c = 0; c < 31; ++c) { const h4 kvh = KV[(size_t)(bh * 32 + c) * 8192 + off]; const f32x4 kv = {(float)kvh[0], (float)kvh[1], (float)kvh[2], (float)kvh[3]}; s = s * gch + kv;
            h4 o; o[0] = (half_t)s[0]; o[1] = (half_t)s[1]; o[2] = (half_t)s[2]; o[3] = (half_t)s[3];
            ST[(size_t)(bh * 32 + c + 1) * 8192 + off] = o; }
    }
}

__device__ __forceinline__ void ret_out_item(const Params& p, int l, LAS unsigned char* lds, int item, int tid, int wave, int lane) {
    const int b = item >> 8, h = (item >> 5) & 7, c = item & 31, tb = b * SEQ + c * 128;
    const float logg = ret_logg(h);
    const half_t* PR = (const half_t*)(p.ws + WS_PROJ); const float* rot = (const float*)(p.ws + WS_ROT);
    const LAS half_t* Ks = (const LAS half_t*)lds; const LAS half_t* Vs = (const LAS half_t*)(lds + RV_OFF);
    const int g = lane >> 4, r = lane & 15, q = (lane & 15) >> 2, pp = lane & 3;
    const int ntile = wave < 4 ? wave : 11 - wave;
    const int n0 = ntile * 16, nq = n0 + r, tok = tb + nq;
    h8 xq[4]; f32x4 rc[2][2], rs[2][2];
#pragma unroll
    for (int ks = 0; ks < 4; ++ks) xq[ks] = *(const h8*)(PR + (size_t)tok * NIN + C_RQ + h * 128 + ks * 32 + g * 8);
#pragma unroll
    for (int ks = 0; ks < 2; ++ks) { const float* cp = rot + (size_t)(c * 128 + nq) * 64 + ks * 32 + g * 8; const float* sp = cp + SEQ * 64;
        rc[ks][0] = *(const f32x4*)cp; rc[ks][1] = *(const f32x4*)(cp + 4); rs[ks][0] = *(const f32x4*)sp; rs[ks][1] = *(const f32x4*)(sp + 4); }
    ret_stage<false>(p, lds, tb, h, c, logg, tid);
    h8 qf[4], qx[4];
    { const float xi = __expf(logg * (float)(nq + 1));
#pragma unroll
      for (int ks = 0; ks < 2; ++ks) {
#pragma unroll
          for (int e = 0; e < 8; ++e) { const float co = e < 4 ? rc[ks][0][e & 3] : rc[ks][1][e & 3], si = e < 4 ? rs[ks][0][e & 3] : rs[ks][1][e & 3]; const float a = (float)xq[ks][e], bb = (float)xq[ks + 2][e];
              const float y1 = a * co - bb * si, y2 = bb * co + a * si;
              qf[ks][e] = (half_t)y1; qf[ks + 2][e] = (half_t)y2; qx[ks][e] = (half_t)(y1 * xi); qx[ks + 2][e] = (half_t)(y2 * xi); } } }
    f32x4 o[16];
#pragma unroll
    for (int i = 0; i < 16; ++i) o[i] = (f32x4){0.f, 0.f, 0.f, 0.f};
    if (c > 0) {
        const half_t* Sp = (const half_t*)(p.ws + WS_ST) + (size_t)item * 32768;
#pragma unroll
        for (int dvt = 0; dvt < 16; ++dvt) {
#pragma unroll
            for (int ks = 0; ks < 4; ++ks) { const h8 af = *(const h8*)(Sp + (size_t)(((dvt * 4 + ks) * 64 + lane) * 8));
                o[dvt] = __builtin_amdgcn_mfma_f32_16x16x32_f16(af, qx[ks], o[dvt], 0, 0, 0); } }
    }
    __syncthreads();
#pragma unroll
    for (int pr = 0; pr < 4; ++pr) {
        if (2 * pr <= ntile) {
            f32x4 s0 = {0.f, 0.f, 0.f, 0.f}, s1 = {0.f, 0.f, 0.f, 0.f};
#pragma unroll
            for (int ks = 0; ks < 4; ++ks) { const h8 a0 = *(const LAS h8*)(Ks + (32 * pr + r) * KSTR + ks * 32 + g * 8), a1 = *(const LAS h8*)(Ks + (32 * pr + 16 + r) * KSTR + ks * 32 + g * 8);
                s0 = __builtin_amdgcn_mfma_f32_16x16x32_f16(a0, qf[ks], s0, 0, 0, 0); s1 = __builtin_amdgcn_mfma_f32_16x16x32_f16(a1, qf[ks], s1, 0, 0, 0); }
            h8 bp;
#pragma unroll
            for (int e = 0; e < 4; ++e) { const int d0 = nq - (32 * pr + 4 * g + e), d1 = d0 - 16;
                bp[e] = (half_t)(d0 >= 0 ? s0[e] * __expf(logg * (float)d0) : 0.f); bp[4 + e] = (half_t)(d1 >= 0 ? s1[e] * __expf(logg * (float)d1) : 0.f); }
#pragma unroll
            for (int dvt = 0; dvt < 16; ++dvt) { const LAS half_t* vp = Vs + (32 * pr + 4 * g + q) * VSTR + dvt * 16 + 4 * pp;
                const h8 af = cat8(tr_read(vp), tr_read(vp + 16 * VSTR));
                o[dvt] = __builtin_amdgcn_mfma_f32_16x16x32_f16(af, bp, o[dvt], 0, 0, 0); }
        }
    }
    float sum = 0.f;
#pragma unroll
    for (int i = 0; i < 16; ++i) sum += (o[i][0] + o[i][1]) + (o[i][2] + o[i][3]);
    sum += shx(sum, lane, 16); sum += shx(sum, lane, 32);
    const float mu = sum * (1.f / 256.f);
    float vs = 0.f;
#pragma unroll
    for (int i = 0; i < 16; ++i) { o[i] = o[i] - mu; vs += (o[i][0] * o[i][0] + o[i][1] * o[i][1]) + (o[i][2] * o[i][2] + o[i][3] * o[i][3]); }
    vs += shx(vs, lane, 16); vs += shx(vs, lane, 32);
    const float rstd = 1.0f / sqrtf(vs * (1.f / 256.f) + EPS);
    half_t* RA = (half_t*)(p.ws + WS_RA);
#pragma unroll
    for (int dvt = 0; dvt < 16; ++dvt) { const int col = h * 256 + dvt * 16 + 4 * g;
        const f32x4 gw = *(const f32x4*)(p.gn_w + l * DM + col); const h4 rg = *(const h4*)(PR + (size_t)tok * NIN + C_RG + col);
        h4 y;
#pragma unroll
        for (int e = 0; e < 4; ++e) y[e] = op16(o[dvt][e] * rstd * gw[e] * siluf((float)rg[e]), TAIL_BF16);
        *(h4*)(RA + (size_t)tok * 4096 + col) = y; }
    __syncthreads();
}

constexpr int SSTR = 72; constexpr int SV_OFF = 272 * SSTR * 2;
__device__ __forceinline__ void swa_item(const Params& p, int l, LAS unsigned char* lds, int item, int tid, int wave, int lane) {
    const int b = item >> 8, nb = (item >> 3) & 31, kvh = item & 7, tb = b * SEQ + nb * 128;
    const half_t* PR = (const half_t*)(p.ws + WS_PROJ);
    LAS half_t* Ks = (LAS half_t*)lds; LAS half_t* Vs = (LAS half_t*)(lds + SV_OFF);
    const h8 z8 = {0, 0, 0, 0, 0, 0, 0, 0};
    const int g = lane >> 4, r = lane & 15, q = (lane & 15) >> 2, pp = lane & 3;
    const int tok = tb + wave * 16 + r;
    h8 qfa[4][2];
#pragma unroll
    for (int gi = 0; gi < 4; ++gi)
#pragma unroll
        for (int ks = 0; ks < 2; ++ks) qfa[gi][ks] = *(const h8*)(PR + (size_t)tok * NIN + C_SQ + (kvh * 4 + gi) * 64 + ks * 32 + g * 8);
#pragma unroll
    for (int i = 0; i < 4; ++i) { const int id = tid + 512 * i, row = id >> 3, ch = id & 7;
        h8 kk = z8, vv = z8;
        if (nb > 0 || row >= 128) { const half_t* src = PR + (size_t)(tb - 128 + row) * NIN + kvh * 64 + ch * 8; kk = *(const h8*)(src + C_SK); vv = *(const h8*)(src + C_SV); }
        *(LAS h8*)(Ks + row * SSTR + ch * 8) = kk; *(LAS h8*)(Vs + row * SSTR + ch * 8) = vv; }
    if (tid < 128) { const int row = 256 + (tid >> 3), ch = tid & 7; *(LAS h8*)(Ks + row * SSTR + ch * 8) = z8; *(LAS h8*)(Vs + row * SSTR + ch * 8) = z8; }
    __syncthreads();
    half_t* RA = (half_t*)(p.ws + WS_RA);
#pragma unroll
    for (int gi = 0; gi < 4; ++gi) {
        const int hq = kvh * 4 + gi;
        __builtin_amdgcn_sched_barrier(0);
        h8 qf[2]; qf[0] = qfa[gi][0]; qf[1] = qfa[gi][1];
        f32x4 s[9];
#pragma unroll
        for (int t = 0; t < 9; ++t) { s[t] = (f32x4){0.f, 0.f, 0.f, 0.f};
#pragma unroll
            for (int ks = 0; ks < 2; ++ks) { const h8 a = *(const LAS h8*)(Ks + ((wave + t) * 16 + r) * SSTR + ks * 32 + g * 8);
                s[t] = __builtin_amdgcn_mfma_f32_16x16x32_f16(a, qf[ks], s[t], 0, 0, 0); } }
        const float SC2 = 0.125f * 1.44269504f;
        const float sink2 = p.sinks[l * 32 + hq] * 1.44269504f;
        const int rg4 = r - 4 * g;
        float m = sink2;
#pragma unroll
        for (int t = 0; t < 9; ++t) { const bool tile_ok = (nb > 0) || (wave + t >= 8);
#pragma unroll
            for (int e = 0; e < 4; ++e) { bool ok = tile_ok; if (t == 0) ok = ok && (rg4 < e); if (t == 8) ok = ok && (rg4 >= e);
                const float v = ok ? s[t][e] * SC2 : -INFINITY; s[t][e] = v; m = fmaxf(m, v); } }
        m = fmaxf(m, shx(m, lane, 16)); m = fmaxf(m, shx(m, lane, 32));
        float ls = 0.f;
#pragma unroll
        for (int t = 0; t < 9; ++t)
#pragma unroll
            for (int e = 0; e < 4; ++e) { const float pv = ex2(s[t][e] - m); s[t][e] = pv; ls += pv; }
        ls += shx(ls, lane, 16); ls += shx(ls, lane, 32);
        ls += ex2(sink2 - m);
        const float inv = __builtin_amdgcn_rcpf(ls);
        f32x4 o[4];
#pragma unroll
        for (int i = 0; i < 4; ++i) o[i] = (f32x4){0.f, 0.f, 0.f, 0.f};
#pragma unroll
        for (int pr = 0; pr < 5; ++pr) {
            h8 bp;
#pragma unroll
            for (int e = 0; e < 4; ++e) { bp[e] = (half_t)s[2 * pr][e]; bp[4 + e] = (pr < 4) ? (half_t)s[(pr < 4) ? 2 * pr + 1 : 0][e] : (half_t)0.f; }
#pragma unroll
            for (int mt = 0; mt < 4; ++mt) { const LAS half_t* vp = Vs + ((wave + 2 * pr) * 16 + 4 * g + q) * SSTR + mt * 16 + 4 * pp;
                const h8 af = cat8(tr_read(vp), tr_read(vp + 16 * SSTR));
                o[mt] = __builtin_amdgcn_mfma_f32_16x16x32_f16(af, bp, o[mt], 0, 0, 0); }
        }
#pragma unroll
        for (int mt = 0; mt < 4; ++mt) { const int col = hq * 64 + mt * 16 + 4 * g;
            const h4 sg = *(const h4*)(PR + (size_t)tok * NIN + C_SG + col);
            h4 y;
#pragma unroll
            for (int e = 0; e < 4; ++e) y[e] = op16(o[mt][e] * inv * siluf((float)sg[e]), TAIL_BF16);
            *(h4*)(RA + (size_t)tok * 4096 + 2048 + col) = y; }
    }
    __syncthreads();
}

#define XB_TMO      128
#define XB_XCNT(j)  (256  + 64 * (j))
#define XB_XSUB(j)  (1280 + 64 * (j))
#define XB_XGEN(j)  (2304 + 64 * (j))
#define XB_TOP      3328
#define XB_TOPGEN   3392
#define XCD_BAR_WORDS 3456
#define XB_SPIN_CAP (1u << 18)

__device__ __forceinline__ unsigned xb_ld(unsigned* p)              { return __hip_atomic_load(p, __ATOMIC_RELAXED, __HIP_MEMORY_SCOPE_AGENT); }
__device__ __forceinline__ unsigned xb_add(unsigned* p, unsigned v) { return __hip_atomic_fetch_add(p, v, __ATOMIC_RELAXED, __HIP_MEMORY_SCOPE_AGENT); }
__device__ __forceinline__ unsigned xb_xcc_id() { return (unsigned)__builtin_amdgcn_s_getreg((3 << 11) | 20) & 0xFu; }
#define XB_SPIN(cond, bar) do { unsigned _sp = 0; while (cond) { __builtin_amdgcn_s_sleep(1); \
    if ((++_sp & 255u) == 0u) { if (xb_ld(&(bar)[XB_TMO])) break; if (_sp > XB_SPIN_CAP) { atomicAdd(&(bar)[XB_TMO], 1u); break; } } } } while (0)

struct XcdBarrier {
    unsigned* bar; unsigned x;
    volatile LAS unsigned* st;
};

__device__ __forceinline__ XcdBarrier xcd_barrier_post(unsigned* bar, volatile LAS unsigned* st) {
    XcdBarrier b; b.bar = bar; b.x = xb_xcc_id(); b.st = st;
    if (threadIdx.x == 0) (void)xb_add(&bar[XB_XCNT(b.x)], 1u);
    return b;
}
__device__ __forceinline__ void xcd_barrier_complete(unsigned* bar, unsigned x, unsigned& nloc, unsigned& nx) {
    const unsigned G = gridDim.x * gridDim.y * gridDim.z;
    unsigned sum, cnt, mine, sp = 0u;
    for (;;) {
        sum = 0u; cnt = 0u; mine = 0u;
#pragma unroll
        for (unsigned j = 0; j < 16; ++j) { const unsigned c = xb_ld(&bar[XB_XCNT(j)]); sum += c; cnt += (c > 0u) ? 1u : 0u; mine = (j == x) ? c : mine; }
        if (sum == G) break;
        __builtin_amdgcn_s_sleep(1);
        if ((++sp & 255u) == 0u) { if (xb_ld(&bar[XB_TMO])) break; if (sp > XB_SPIN_CAP) { atomicAdd(&bar[XB_TMO], 1u); break; } }
    }
    nloc = mine > 0u ? mine : 1u; nx = cnt > 0u ? cnt : 1u;
}

__device__ __forceinline__ void xcd_barrier(const XcdBarrier& b) {
    asm volatile("s_waitcnt vmcnt(0)" ::: "memory");
    __syncthreads();
    if (threadIdx.x == 0) {
        unsigned* bar = b.bar;
        __builtin_amdgcn_s_waitcnt(0);
        unsigned nloc = b.st[0], nx = b.st[1];
        if (nloc == 0u) { xcd_barrier_complete(bar, b.x, nloc, nx); b.st[0] = nloc; b.st[1] = nx; }
        const unsigned old = xb_add(&bar[XB_XSUB(b.x)], 1u);
        const unsigned gen = old / nloc;
        if (old + 1u == (gen + 1u) * nloc) {
            __builtin_amdgcn_fence(__ATOMIC_RELEASE, "agent");
            asm volatile("s_waitcnt vmcnt(0)" ::: "memory");
            const unsigned og = xb_add(&bar[XB_TOP], 1u);
            const unsigned tg = og / nx;
            if (og + 1u == (tg + 1u) * nx) xb_add(&bar[XB_TOPGEN], 1u);
            else XB_SPIN(xb_ld(&bar[XB_TOPGEN]) == tg, bar);
            __builtin_amdgcn_fence(__ATOMIC_ACQUIRE, "agent");
            xb_add(&bar[XB_XGEN(b.x)], 1u);
            asm volatile("s_waitcnt vmcnt(0)" ::: "memory");
        } else {
            XB_SPIN(xb_ld(&bar[XB_XGEN(b.x)]) == gen, bar);
            __builtin_amdgcn_fence(__ATOMIC_ACQUIRE, "agent");
            asm volatile("s_waitcnt vmcnt(0)" ::: "memory");
        }
    }
    __syncthreads();
}

__global__ void __launch_bounds__(512, 2) hybrid_fwd(Params p) {
    extern __shared__ __attribute__((aligned(16))) unsigned char shm[];
    LAS unsigned char* lds = (LAS unsigned char*)shm;
    cg::grid_group grid = cg::this_grid();
    const int tid = threadIdx.x, G = gridDim.x;
    unsigned char* ws = p.ws;
    volatile LAS unsigned* ctlw = (volatile LAS unsigned*)(lds + 131072);
    if (tid < 64) ctlw[tid] = 0u;
    __syncthreads();
    const XcdBarrier xbar = xcd_barrier_post((unsigned*)(ws + WS_BAR), ctlw + 8);
#define GRID_BAR() xcd_barrier(xbar)

#define LAUNDER() int t2 = tid; asm volatile("" : "+v"(t2)); const int w2 = __builtin_amdgcn_readfirstlane(t2 >> 6), l2 = t2 & 63; (void)w2; (void)l2;
    { LAUNDER(); phase_prep(p, lds, t2, w2, l2, G); }
    if (G == 0x7fffffff) grid.sync();
    GRID_BAR();
    for (int l = 0; l < DEPTH; ++l) {
        { LAUNDER(); if (l == 0) phase_u(p, 0, p.x, w2, l2, G); else phase_u_h(p, l, w2, l2, G); }
        GRID_BAR();
        { LAUNDER();
          const bool side = (G == 256) && (l + 1 < DEPTH); const int GG = side ? 240 : G;
          if ((int)blockIdx.x < GG) {
              pg8::Gemm gm{(const half_t*)(ws + WS_U), (const half_t*)(ws + WS_WIN + l * SZ_WIN), NTOK, NIN, DM}; pg8::StaticOrder S; S.init(NTOK, NIN, GG, blockIdx.x);
              EpiProj E{(half_t*)(ws + WS_PROJ)}; pg8::gemm_phase<EpiProj>(lds, gm, S, E, t2);
          } else {
              convert_range(p, l + 1, 0, I_IN, (LAS float*)(lds + w2 * 8704), ((int)blockIdx.x - GG) * 8 + w2, (G - GG) * 8, l2);
          } }
        GRID_BAR();
        { LAUNDER(); for (int it = blockIdx.x; it < 1024; it += G) { if (it < 512) swa_item(p, l, lds, it, t2, w2, l2); else ret_kv_item(p, lds, it - 512, t2, w2, l2); } }
        GRID_BAR();
        { LAUNDER(); phase_scan(p, t2, G); }
        GRID_BAR();
        { LAUNDER(); for (int it = blockIdx.x; it < 512; it += G) ret_out_item(p, l, lds, it, t2, w2, l2); }
        GRID_BAR();
        { LAUNDER(); pg8::Gemm gm{(const half_t*)(ws + WS_RA), (const half_t*)(ws + WS_WMRG + l * SZ_WMRG), NTOK, DM, 4096}; pg8::StaticOrder S; S.init(NTOK, DM, G, blockIdx.x);
          EpiMerge E{(const half_t*)(ws + WS_PROJ), (half_t*)(ws + WS_MRG)}; pg8::gemm_phase<EpiMerge>(lds, gm, S, E, t2); }
        GRID_BAR();
        { LAUNDER(); pg8::Gemm gm{(const half_t*)(ws + WS_MRG), (const half_t*)(ws + WS_WOUT + l * SZ_WOUT), NTOK, DM, DM}; pg8::StaticOrder S; S.init(NTOK, DM, G, blockIdx.x);
          const float* gatep = (const float*)(ws + WS_MOD) + (size_t)l * 2 * 6144 + 4096;
          if (l == 0) { EpiOut<true> E{p.x, gatep, (half_t*)(ws + WS_H)}; pg8::gemm_phase<EpiOut<true>>(lds, gm, S, E, t2); }
          else { EpiOut<false> E{nullptr, gatep, (half_t*)(ws + WS_H)}; pg8::gemm_phase<EpiOut<false>>(lds, gm, S, E, t2); } }
        GRID_BAR();
    }
    { LAUNDER(); phase_final(p, w2, l2, G); }
}

extern "C" void kernel_launch(void* const* d_in, const int* in_sizes, int n_in, void* d_out, int out_size, void* d_ws, size_t ws_size, hipStream_t stream) {
    static int grid = 0;
    if (grid == 0) {
        if (n_in != 12 || out_size != NTOK * DM || ws_size < WS_END) { fprintf(stderr, "kernel_launch: unexpected shapes / workspace (%d inputs, out %d, ws %zu < %zu)\n", n_in, out_size, ws_size, (size_t)WS_END); grid = -1; return; }
        int dev = 0, cus = 0, per_cu = 0;
        (void)hipGetDevice(&dev);
        (void)hipDeviceGetAttribute(&cus, hipDeviceAttributeMultiprocessorCount, dev);
        if (hipFuncSetAttribute((const void*)hybrid_fwd, hipFuncAttributeMaxDynamicSharedMemorySize, LDS_BYTES) != hipSuccess) { fprintf(stderr, "kernel_launch: hipFuncSetAttribute failed\n"); grid = -1; return; }
        if (hipOccupancyMaxActiveBlocksPerMultiprocessor(&per_cu, (const void*)hybrid_fwd, 512, LDS_BYTES) != hipSuccess || per_cu < 1) { fprintf(stderr, "kernel_launch: occupancy query failed (%d)\n", per_cu); per_cu = 1; }
        (void)hipGetLastError();
        grid = cus * per_cu;
        fprintf(stderr, "kernel_launch: grid %d (%d CUs x %d)\n", grid, cus, per_cu);
    }
    if (grid < 0) return;
    Params p{};
    p.x = (const float*)d_in[0]; p.c = (const float*)d_in[1]; p.norm_w = (const float*)d_in[2]; p.ada_w = (const float*)d_in[3]; p.ada_b = (const float*)d_in[4];
    p.w_in = (const float*)d_in[5]; p.gn_w = (const float*)d_in[6]; p.sinks = (const float*)d_in[7]; p.w_ret_o = (const float*)d_in[8]; p.w_swa_o = (const float*)d_in[9];
    p.w_out = (const float*)d_in[10]; p.fnorm_w = (const float*)d_in[11]; p.out = (float*)d_out; p.ws = (unsigned char*)d_ws;
    if (hipMemsetAsync((unsigned char*)d_ws + WS_BAR, 0, 16384, stream) != hipSuccess) { fprintf(stderr, "kernel_launch: memset of barrier words failed\n"); return; }
    void* args[] = {&p};
    hipError_t e = hipLaunchCooperativeKernel((const void*)hybrid_fwd, dim3(grid), dim3(512), args, LDS_BYTES, stream);
    if (e != hipSuccess) fprintf(stderr, "kernel_launch: cooperative launch failed: %s (grid %d)\n", hipGetErrorString(e), grid);
}
```

```cpp
#include <hip/hip_runtime.h>
#include <hip/hip_cooperative_groups.h>
#include <cstdio>
#include <cstdint>
namespace cg = cooperative_groups;

#define LAS __attribute__((address_space(3)))
typedef _Float16 half_t;
typedef _Float16 h8 __attribute__((ext_vector_type(8)));
typedef _Float16 h4 __attribute__((ext_vector_type(4)));
typedef short s4v __attribute__((ext_vector_type(4)));
typedef float f32x4 __attribute__((ext_vector_type(4)));
typedef short s8v __attribute__((ext_vector_type(8)));
constexpr bool INPROJ_BF16 = true;
constexpr bool TAIL_BF16 = true;
__device__ __forceinline__ half_t op16(float f, bool bf) { return bf ? __builtin_bit_cast(half_t, (__bf16)f) : (half_t)f; }

constexpr int SEQ = 4096, NTOK = 8192, DM = 2048, NIN = 15360, DEPTH = 4;
constexpr int C_RQ = 0, C_RK = 1024, C_RV = 2048, C_RG = 4096, C_SQ = 6144, C_SK = 8192, C_SV = 8704, C_SG = 9216, C_MR = 11264, C_MS = 13312;
constexpr float EPS = 1e-6f;
constexpr size_t SZ_WIN = (size_t)NIN * DM * 2, SZ_WMRG = (size_t)DM * 4096 * 2, SZ_WOUT = (size_t)DM * DM * 2;
constexpr size_t WS_WIN = 0;
constexpr size_t WS_WMRG = WS_WIN + DEPTH * SZ_WIN;
constexpr size_t WS_WOUT = WS_WMRG + DEPTH * SZ_WMRG;
constexpr size_t WS_MOD = WS_WOUT + DEPTH * SZ_WOUT;
constexpr size_t WS_ROT = WS_MOD + (size_t)DEPTH * 2 * 6144 * 4;
constexpr size_t WS_U = WS_ROT + (size_t)2 * SEQ * 64 * 4;
constexpr size_t WS_PROJ = WS_U + (size_t)NTOK * DM * 2;
constexpr size_t WS_RA = WS_PROJ + (size_t)NTOK * NIN * 2;
constexpr size_t WS_MRG = WS_RA + (size_t)NTOK * 4096 * 2;
constexpr size_t WS_H = WS_MRG + (size_t)NTOK * DM * 2;
constexpr size_t WS_KV = WS_H + (size_t)NTOK * DM * 4;
constexpr size_t WS_ST = WS_KV + (size_t)512 * 32768 * 4;
constexpr size_t WS_BAR = WS_ST + (size_t)512 * 32768 * 2;
constexpr size_t WS_END = WS_BAR + 16384;
constexpr int LDS_BYTES = 131072 + 256;

struct Params {
    const float *x, *c, *norm_w, *ada_w, *ada_b, *w_in, *gn_w, *sinks, *w_ret_o, *w_swa_o, *w_out, *fnorm_w;
    float* out; unsigned char* ws;
};

namespace pg8 {
constexpr int BM = 256, BK = 64, HALF = 128, HTB = HALF * BK * 2, STAGE_BYTES = 8 * HTB, NXCD = 8, WGM = 4;
__host__ __device__ __forceinline__ int lds_byte(int r, int c) { const int st = (r >> 4) * 2 + (c >> 5), rr = r & 15, cc = c & 31, ob = rr * 64 + cc * 2; return st * 1024 + (ob ^ (((ob >> 9) & 1) << 5)); }
__host__ __device__ __forceinline__ void stage_rc(int b, int& R, int& C) { const int st = b / 1024, sb = b % 1024, swz = sb ^ (((sb >> 9) & 1) << 5); R = (st >> 1) * 16 + swz / 64; C = (st & 1) * 32 + (swz % 64) / 2; }
__host__ __device__ __forceinline__ int perm32(int rho) { const int n = rho >> 4, i = rho & 15; return 8 * (i >> 2) + 4 * n + (i & 3); }

struct Unit { int pm, pn; };
struct Gemm { const half_t* A; const half_t* Bt; int M, N, K; };

struct StaticOrder {
    int nM, nN, nwg, G, c;
    __device__ void init(int M, int N, int G_, int c_) { nM = M / BM; nN = N / BM; nwg = nM * nN; G = G_; c = c_; }
    __device__ bool next(int i, Unit& u) const {
        const long L = (long)i * G + c; if (L >= nwg) return false;
        int wgid = (int)L; { const int q = nwg / NXCD, r = nwg % NXCD, xcd = wgid % NXCD, off = wgid / NXCD; wgid = (xcd < r ? xcd * (q + 1) : r * (q + 1) + (xcd - r) * q) + off; }
        const int nig = WGM * nN, gid = wgid / nig, fm = gid * WGM, gsz = (nM - fm) < WGM ? (nM - fm) : WGM;
        u.pm = fm + ((wgid % nig) % gsz); u.pn = (wgid % nig) / gsz; return true;
    }
};

template <class Epi>
__device__ __forceinline__ void gemm_phase(LAS unsigned char* lds, const Gemm g, const StaticOrder& S, const Epi& E, const int tid) {
    const int wid = __builtin_amdgcn_readfirstlane(tid >> 6), lane = tid & 63, wr = wid >> 2, wc = wid & 3, fr = lane & 15, fq = lane >> 4;
    const int K = g.K, nt = K / BK;
    unsigned voffA[2], voffB[2];
#pragma unroll
    for (int i = 0; i < 2; ++i) { int R, C; stage_rc(tid * 16 + i * 8192, R, C); const int Rb = Epi::BJ_ADJ ? ((R >> 5) * 64 + perm32(R & 31)) : (Epi::PERM ? ((R & ~31) + perm32(R & 31)) : R);
        voffA[i] = (unsigned)(R * K + C) * 2u; voffB[i] = (unsigned)(Rb * K + C) * 2u; }
    const size_t kstep = (size_t)(BK * 2);
    const size_t hstep = (size_t)HALF * K * 2;
    const size_t tstep = 2 * hstep;
    const size_t hstepB = Epi::BJ_ADJ ? (size_t)32 * K * 2 : hstep;
    const unsigned ldsw = (unsigned)wid * 1024u;
    const int aoff = lds_byte(wr * 64 + fr, fq * 8), boff = lds_byte(wc * 32 + fr, fq * 8);
#define PG8_SA(b, h) (((b) * 2 + (h)) * HTB)
#define PG8_SB(b, h) ((4 + (b) * 2 + (h)) * HTB)
#define PG8_STAGE(bufoff, gbase, voff) do { _Pragma("unroll") for (int _i = 0; _i < 2; ++_i) \
        __builtin_amdgcn_global_load_lds((const unsigned*)((const char*)(gbase) + (voff)[_i]), (LAS unsigned*)(lds + (bufoff) + ldsw + _i * 8192), 16, 0, 0); } while (0)
#define PG8_LDA(dst, b, h) do { _Pragma("unroll") for (int m = 0; m < 4; ++m) _Pragma("unroll") for (int k = 0; k < 2; ++k) dst[m][k] = *(const LAS h8*)(lds + PG8_SA(b, h) + aoff + m * 2048 + k * 1024); } while (0)
#define PG8_LDB(dst, b, h) do { _Pragma("unroll") for (int n = 0; n < 2; ++n) _Pragma("unroll") for (int k = 0; k < 2; ++k) dst[n][k] = *(const LAS h8*)(lds + PG8_SB(b, h) + boff + n * 2048 + k * 1024); } while (0)
#define PG8_MMA(ai, bj, At, Bt) do { __builtin_amdgcn_s_setprio(1); _Pragma("unroll") for (int m = 0; m < 4; ++m) _Pragma("unroll") for (int n = 0; n < 2; ++n) _Pragma("unroll") for (int k = 0; k < 2; ++k) \
        { if constexpr (Epi::BF16) acc[ai][bj][m][n] = __builtin_amdgcn_mfma_f32_16x16x32_bf16(__builtin_bit_cast(s8v, Bt[n][k]), __builtin_bit_cast(s8v, At[m][k]), acc[ai][bj][m][n], 0, 0, 0); \
          else acc[ai][bj][m][n] = __builtin_amdgcn_mfma_f32_16x16x32_f16(Bt[n][k], At[m][k], acc[ai][bj][m][n], 0, 0, 0); } __builtin_amdgcn_s_setprio(0); } while (0)
#define PG8_WAIT_V(n) asm volatile("s_waitcnt vmcnt(" #n ")" ::: "memory")
#define PG8_WAIT_L(n) asm volatile("s_waitcnt lgkmcnt(" #n ")" ::: "memory")
#define PG8_BAR __builtin_amdgcn_s_barrier()
#define PG8_SCHED __builtin_amdgcn_sched_barrier(0)
    Unit cur, nxt; int ui = 0;
    if (!S.next(0, cur)) return;
    f32x4 acc[2][2][4][2];
#pragma unroll
    for (int a = 0; a < 2; ++a)
#pragma unroll
        for (int b = 0; b < 2; ++b)
#pragma unroll
            for (int m = 0; m < 4; ++m)
#pragma unroll
                for (int n = 0; n < 2; ++n) acc[a][b][m][n] = (f32x4){0.f, 0.f, 0.f, 0.f};
    h8 At[4][2], B0[2][2], B1[2][2];
    const char* cA = (const char*)g.A + (size_t)cur.pm * tstep; const char* cB = (const char*)g.Bt + (size_t)cur.pn * tstep;
    PG8_STAGE(PG8_SB(0, 0), cB, voffB); PG8_STAGE(PG8_SA(0, 0), cA, voffA); PG8_STAGE(PG8_SB(0, 1), cB + hstepB, voffB); PG8_STAGE(PG8_SA(0, 1), cA + hstep, voffA);
    if (wr == 1) PG8_BAR;
    PG8_WAIT_V(4); PG8_BAR;
    PG8_STAGE(PG8_SB(1, 0), cB + kstep, voffB); PG8_STAGE(PG8_SA(1, 0), cA + kstep, voffA); PG8_STAGE(PG8_SB(1, 1), cB + hstepB + kstep, voffB);
    PG8_WAIT_V(6); PG8_BAR;
    for (;;) {
        const bool has_next = S.next(ui + 1, nxt);
        const char* nA = has_next ? (const char*)g.A + (size_t)nxt.pm * tstep : cA; const char* nB = has_next ? (const char*)g.Bt + (size_t)nxt.pn * tstep : cB;
        for (int t = 0; t < nt; t += 2) {
            const bool last = (t == nt - 2);
            const char* a1 = cA + (size_t)(t + 1) * kstep;
            const char* a2 = last ? nA : cA + (size_t)(t + 2) * kstep; const char* b2 = last ? nB : cB + (size_t)(t + 2) * kstep;
            const char* a3 = a2 + kstep; const char* b3 = b2 + kstep;
            if constexpr (Epi::HAS_MID) { if (t == (nt >> 1)) E.mid(acc, cur, wr, wc, fr, fq); }
            PG8_LDB(B0, 0, 0); PG8_SCHED; PG8_LDA(At, 0, 0); PG8_STAGE(PG8_SA(1, 1), a1 + hstep, voffA);
            PG8_WAIT_L(8); PG8_BAR; PG8_WAIT_L(0); PG8_MMA(0, 0, At, B0); PG8_BAR; PG8_SCHED;
            PG8_LDB(B1, 0, 1); PG8_STAGE(PG8_SB(0, 0), b2, voffB);
            PG8_BAR; PG8_WAIT_L(0); PG8_MMA(0, 1, At, B1); PG8_BAR;
            PG8_LDA(At, 0, 1); PG8_STAGE(PG8_SA(0, 0), a2, voffA);
            PG8_BAR; PG8_WAIT_L(0); PG8_MMA(1, 0, At, B0); PG8_BAR; PG8_SCHED;
            PG8_STAGE(PG8_SB(0, 1), b2 + hstepB, voffB);
            PG8_WAIT_V(6); PG8_BAR; PG8_MMA(1, 1, At, B1); PG8_BAR;
            PG8_LDB(B0, 1, 0); PG8_SCHED; PG8_LDA(At, 1, 0); PG8_STAGE(PG8_SA(0, 1), a2 + hstep, voffA);
            PG8_WAIT_L(8); PG8_BAR; PG8_WAIT_L(0); PG8_MMA(0, 0, At, B0); PG8_BAR; PG8_SCHED;
            PG8_LDB(B1, 1, 1); PG8_STAGE(PG8_SB(1, 0), b3, voffB);
            PG8_BAR; PG8_WAIT_L(0); PG8_MMA(0, 1, At, B1); PG8_BAR;
            PG8_LDA(At, 1, 1); PG8_STAGE(PG8_SA(1, 0), a3, voffA);
            PG8_BAR; PG8_WAIT_L(0); PG8_MMA(1, 0, At, B0); PG8_BAR; PG8_SCHED;
            PG8_STAGE(PG8_SB(1, 1), b3 + hstepB, voffB);
            PG8_WAIT_V(6); PG8_BAR; PG8_MMA(1, 1, At, B1); PG8_BAR;
        }
        E(acc, cur, wr, wc, fr, fq);
        if (!has_next) break;
#pragma unroll
        for (int a = 0; a < 2; ++a)
#pragma unroll
            for (int b = 0; b < 2; ++b)
#pragma unroll
                for (int m = 0; m < 4; ++m)
#pragma unroll
                    for (int n = 0; n < 2; ++n) acc[a][b][m][n] = (f32x4){0.f, 0.f, 0.f, 0.f};
        cur = nxt; cA = nA; cB = nB; ++ui;
    }
    PG8_WAIT_V(0);
    if (wr == 0) PG8_BAR;
    PG8_BAR;
#undef PG8_SA
#undef PG8_SB
#undef PG8_STAGE
#undef PG8_LDA
#undef PG8_LDB
#undef PG8_MMA
#undef PG8_WAIT_V
#undef PG8_WAIT_L
#undef PG8_BAR
#undef PG8_SCHED
}
}

__device__ __forceinline__ float shx(float v, int lane, int m) { return __builtin_bit_cast(float, __builtin_amdgcn_ds_bpermute((lane ^ m) << 2, __builtin_bit_cast(int, v))); }
__device__ __forceinline__ float wave_sum(float v, int lane) {
#pragma unroll
    for (int o = 1; o < 64; o <<= 1) v += shx(v, lane, o);
    return v;
}
__device__ __forceinline__ float ex2(float x) { return __builtin_amdgcn_exp2f(x); }
__device__ __forceinline__ float siluf(float x) { return x * __builtin_amdgcn_rcpf(1.f + ex2(x * -1.44269504f)); }
__device__ __forceinline__ h4 tr_read(const LAS half_t* p) { s4v r = __builtin_amdgcn_ds_read_tr16_b64_v4i16((LAS s4v*)p); return __builtin_bit_cast(h4, r); }
__device__ __forceinline__ h8 cat8(h4 a, h4 b) { h8 r; r[0] = a[0]; r[1] = a[1]; r[2] = a[2]; r[3] = a[3]; r[4] = b[0]; r[5] = b[1]; r[6] = b[2]; r[7] = b[3]; return r; }
__device__ __forceinline__ float ret_logg(int h) { return log1pf(-exp2f(-5.f - (float)h)); }

struct EpiProj {
    static constexpr bool PERM = true, HAS_MID = false, BJ_ADJ = true, BF16 = INPROJ_BF16;
    half_t* O;
    typedef int i32x4 __attribute__((ext_vector_type(4)));
    __device__ __forceinline__ void mid(f32x4 (&)[2][2][4][2], const pg8::Unit&, int, int, int, int) const {}
    static __device__ __forceinline__ h8 pack8(const f32x4 v0, const f32x4 v1) { h8 o; o[0] = (half_t)v0[0]; o[1] = (half_t)v0[1]; o[2] = (half_t)v0[2]; o[3] = (half_t)v0[3]; o[4] = (half_t)v1[0]; o[5] = (half_t)v1[1]; o[6] = (half_t)v1[2]; o[7] = (half_t)v1[3]; return o; }
    __device__ __forceinline__ void operator()(f32x4 (&acc)[2][2][4][2], const pg8::Unit& u, int wr, int wc, int fr, int fq) const {
        const bool hi = fr >= 8;
        const int row0 = u.pm * 256 + wr * 64 + (fr & 7), col = u.pn * 256 + wc * 64 + fq * 8 + (hi ? 32 : 0);
#pragma unroll
        for (int ai = 0; ai < 2; ++ai)
#pragma unroll
            for (int m = 0; m < 4; ++m) {
                const h8 x0 = pack8(acc[ai][0][m][0], acc[ai][0][m][1]), x1 = pack8(acc[ai][1][m][0], acc[ai][1][m][1]);
                const i32x4 snd = hi ? __builtin_bit_cast(i32x4, x0) : __builtin_bit_cast(i32x4, x1);
                i32x4 rcv;
#pragma unroll
                for (int d = 0; d < 4; ++d) rcv[d] = __builtin_amdgcn_update_dpp(0, snd[d], 0x128  , 0xF, 0xF, false);
                const h8 rv = __builtin_bit_cast(h8, rcv);
                const h8 vA = hi ? rv : x0;
                const h8 vB = hi ? x1 : rv;
                half_t* rowp = O + (size_t)(row0 + ai * 128 + m * 16) * NIN + col;
                __builtin_nontemporal_store(vA, (h8*)rowp); __builtin_nontemporal_store(vB, (h8*)(rowp + (size_t)8 * NIN)); }
    }
};
struct EpiMerge {
    static constexpr bool PERM = true, HAS_MID = true, BJ_ADJ = false, BF16 = TAIL_BF16;
    const half_t* P; half_t* O;
    __device__ __forceinline__ void mid(f32x4 (&acc)[2][2][4][2], const pg8::Unit& u, int wr, int wc, int fr, int fq) const {
        const int row0 = u.pm * 256 + wr * 64 + fr, col0 = u.pn * 256 + wc * 32 + 8 * fq;
        unsigned base = (unsigned)(row0 * NIN + col0);
        asm volatile("" : "+v"(base));
        const half_t* bp0 = P + base;
#pragma unroll
        for (int ai = 0; ai < 2; ++ai)
#pragma unroll
            for (int m = 0; m < 4; ++m) { const half_t* rowp = bp0 + (size_t)(ai * 128 + m * 16) * NIN;
                __builtin_amdgcn_sched_barrier(0);
#pragma unroll
                for (int bj = 0; bj < 2; ++bj) { const h8 ga = *(const h8*)(rowp + C_MR + bj * 128), gb = *(const h8*)(rowp + C_MS + bj * 128);
#pragma unroll
                    for (int n = 0; n < 2; ++n)
#pragma unroll
                        for (int i = 0; i < 4; ++i) { const float a = (float)ga[4 * n + i], b = (float)gb[4 * n + i];
                            acc[ai][bj][m][n][i] *= (1.f + ex2(b * -1.44269504f)) * __builtin_amdgcn_rcpf(1.f + ex2(a * -1.44269504f)); } } }
    }
    __device__ __forceinline__ void operator()(const f32x4 (&acc)[2][2][4][2], const pg8::Unit& u, int wr, int wc, int fr, int fq) const {
        const int row0 = u.pm * 256 + wr * 64 + fr, col0 = u.pn * 256 + wc * 32 + 8 * fq;
#pragma unroll
        for (int ai = 0; ai < 2; ++ai)
#pragma unroll
            for (int m = 0; m < 4; ++m) { const size_t row = (size_t)(row0 + ai * 128 + m * 16);
#pragma unroll
                for (int bj = 0; bj < 2; ++bj) { const h8 gb = *(const h8*)(P + row * NIN + col0 + C_MS + bj * 128);
                    h8 o;
#pragma unroll
                    for (int n = 0; n < 2; ++n)
#pragma unroll
                        for (int i = 0; i < 4; ++i) o[4 * n + i] = op16(acc[ai][bj][m][n][i] * __builtin_amdgcn_rcpf(1.f + ex2((float)gb[4 * n + i] * -1.44269504f)), TAIL_BF16);
                    *(h8*)(O + row * DM + col0 + bj * 128) = o; } }
    }
};
template <bool XF32>
struct EpiOut {
    static constexpr bool PERM = true, HAS_MID = false, BJ_ADJ = false, BF16 = TAIL_BF16;
    const float* xin; const float* gate; half_t* H;
    __device__ __forceinline__ void mid(f32x4 (&)[2][2][4][2], const pg8::Unit&, int, int, int, int) const {}
    __device__ __forceinline__ void operator()(const f32x4 (&acc)[2][2][4][2], const pg8::Unit& u, int wr, int wc, int fr, int fq) const {
        const int row0 = u.pm * 256 + wr * 64 + fr, col0 = u.pn * 256 + wc * 32 + 8 * fq;
        const float* gp = gate + (size_t)((u.pm * 256) >> 12) * 6144 + col0;
        f32x4 gv[2][2];
#pragma unroll
        for (int bj = 0; bj < 2; ++bj)
#pragma unroll
            for (int n = 0; n < 2; ++n) gv[bj][n] = *(const f32x4*)(gp + bj * 128 + 4 * n);
#pragma unroll
        for (int ai = 0; ai < 2; ++ai)
#pragma unroll
            for (int m = 0; m < 4; ++m) { const size_t ro = (size_t)(row0 + ai * 128 + m * 16) * DM + col0;
#pragma unroll
                for (int bj = 0; bj < 2; ++bj) {
                    f32x4 x0, x1;
                    if (XF32) { x0 = *(const f32x4*)(xin + ro + bj * 128); x1 = *(const f32x4*)(xin + ro + bj * 128 + 4); }
                    else { const h8 xh = *(const h8*)(H + ro + bj * 128); x0 = (f32x4){(float)xh[0], (float)xh[1], (float)xh[2], (float)xh[3]}; x1 = (f32x4){(float)xh[4], (float)xh[5], (float)xh[6], (float)xh[7]}; }
                    const f32x4 y0 = x0 + gv[bj][0] * acc[ai][bj][m][0], y1 = x1 + gv[bj][1] * acc[ai][bj][m][1];
                    h8 o; o[0] = (half_t)y0[0]; o[1] = (half_t)y0[1]; o[2] = (half_t)y0[2]; o[3] = (half_t)y0[3]; o[4] = (half_t)y1[0]; o[5] = (half_t)y1[1]; o[6] = (half_t)y1[2]; o[7] = (half_t)y1[3];
                    *(h8*)(H + ro + bj * 128) = o; } }
    }
};

constexpr int I_IN = 64 * (NIN / 64), I_SQ = 64 * (DM / 64), I_SMALL = 3 * I_SQ;
struct TItem { const float* src; half_t* dst; int N, ldt; bool bf; };
__device__ __forceinline__ TItem titem(const Params& p, int l, int r, int lane) {
    const float* W; half_t* WT; int N, ldt, koff = 0;
    unsigned char* ws = p.ws;
    const bool bf = (r < I_IN) ? INPROJ_BF16 : TAIL_BF16;
    if (r < I_IN) { W = p.w_in + (size_t)l * DM * NIN; N = NIN; WT = (half_t*)(ws + WS_WIN + l * SZ_WIN); ldt = DM; }
    else { r -= I_IN; N = DM;
        if (r < I_SQ) { W = p.w_ret_o + (size_t)l * DM * DM; WT = (half_t*)(ws + WS_WMRG + l * SZ_WMRG); ldt = 4096; }
        else if (r < 2 * I_SQ) { r -= I_SQ; W = p.w_swa_o + (size_t)l * DM * DM; WT = (half_t*)(ws + WS_WMRG + l * SZ_WMRG); ldt = 4096; koff = 2048; }
        else { r -= 2 * I_SQ; W = p.w_out + (size_t)l * DM * DM; WT = (half_t*)(ws + WS_WOUT + l * SZ_WOUT); ldt = DM; } }
    const int nblk = N >> 6, kb = r / nblk, nb = r - kb * nblk, k0 = kb * 32, n0 = nb * 64;
    TItem t; t.N = N; t.ldt = ldt; t.bf = bf;
    t.src = W + (size_t)(k0 + (lane >> 4)) * N + n0 + (lane & 15) * 4;
    t.dst = WT + (size_t)(n0 + (lane >> 2)) * ldt + koff + k0 + 8 * (lane & 3);
    return t;
}
__device__ __forceinline__ void tload(const TItem& t, f32x4 (&v)[8]) {
#pragma unroll
    for (int i = 0; i < 8; ++i) v[i] = *(const f32x4*)(t.src + (size_t)(4 * i) * t.N);
}
__device__ __forceinline__ void tstore(const TItem& t, const f32x4 (&v)[8], LAS float* scr, int lane) {
    const int rr = lane >> 4, c4 = (lane & 15) * 4;
#pragma unroll
    for (int i = 0; i < 8; ++i) *(LAS f32x4*)(scr + (4 * i + rr) * 68 + c4) = v[i];
    asm volatile("s_waitcnt lgkmcnt(0)" ::: "memory");
    const int c = lane & 3;
#pragma unroll
    for (int j = 0; j < 4; ++j) { const int n = (lane >> 2) + 16 * j; const LAS float* s = scr + (8 * c) * 68 + n;
        h8 o;
#pragma unroll
        for (int e = 0; e < 8; ++e) o[e] = op16(s[e * 68], t.bf);
        *(h8*)(t.dst + (size_t)(16 * j) * t.ldt) = o; }
    asm volatile("s_waitcnt lgkmcnt(0)" ::: "memory");
}
__device__ __forceinline__ void convert_range(const Params& p, int l, int lo, int hi, LAS float* scr, int gw, int NGW, int lane) {
    int it = lo + gw;
    if (it >= hi) return;
    f32x4 cur[8], nxt[8];
    TItem tc = titem(p, l, it, lane);
    tload(tc, cur);
    for (;;) {
        const int itn = it + NGW; const bool more = itn < hi;
        TItem tn = tc;
        if (more) { tn = titem(p, l, itn, lane); tload(tn, nxt); }
        tstore(tc, cur, scr, lane);
        if (!more) break;
#pragma unroll
        for (int i = 0; i < 8; ++i) cur[i] = nxt[i];
        tc = tn; it = itn;
    }
}

__device__ __forceinline__ void phase_prep(const Params& p, LAS unsigned char* lds, int tid, int wave, int lane, int G) {
    unsigned char* ws = p.ws;
    float* mod = (float*)(ws + WS_MOD);
    for (int item = blockIdx.x; item < DEPTH * 24; item += G) {
        LAS float* cact = (LAS float*)lds; LAS float* red = (LAS float*)(lds + 16384);
        __syncthreads();
        for (int i = tid; i < 4096; i += 512) { const float cv = p.c[i]; cact[i] = cv / (1.f + expf(-cv)); }
        __syncthreads();
        const int l = item / 24, cgi = item - l * 24;
        const float* W = p.ada_w + (size_t)l * DM * 6144 + cgi * 256 + lane * 4;
        f32x4 a0 = {0.f, 0.f, 0.f, 0.f}, a1 = {0.f, 0.f, 0.f, 0.f};
        const int kb = wave * 256;
        for (int k = kb; k < kb + 256; k += 8) {
            f32x4 w[8];
#pragma unroll
            for (int i = 0; i < 8; ++i) w[i] = *(const f32x4*)(W + (size_t)(k + i) * 6144);
#pragma unroll
            for (int i = 0; i < 8; ++i) { a0 += w[i] * cact[k + i]; a1 += w[i] * cact[2048 + k + i]; }
        }
        *(LAS f32x4*)(red + (wave * 2 + 0) * 256 + lane * 4) = a0;
        *(LAS f32x4*)(red + (wave * 2 + 1) * 256 + lane * 4) = a1;
        __syncthreads();
        { const int b = tid >> 8, col = tid & 255; float s = p.ada_b[l * 6144 + cgi * 256 + col];
#pragma unroll
          for (int w = 0; w < 8; ++w) s += red[(w * 2 + b) * 256 + col];
          mod[(size_t)(l * 2 + b) * 6144 + cgi * 256 + col] = s; }
    }
    __syncthreads();
    { float* rot = (float*)(ws + WS_ROT);
      for (int idx = blockIdx.x * 512 + tid; idx < SEQ * 64; idx += G * 512) { const int pos = idx >> 6, j = idx & 63;
          const float inv = 1.0f / powf(10000.f, (float)j / 63.0f); const float ang = (float)pos * inv;
          rot[idx] = cosf(ang); rot[SEQ * 64 + idx] = sinf(ang); } }
    { LAS float* scr = (LAS float*)(lds + 32768 + wave * 8704);
      const int nb = (DEPTH * 24 < G) ? DEPTH * 24 : 0;
      if ((int)blockIdx.x >= nb) { const int gwa = ((int)blockIdx.x - nb) * 8 + wave, NGA = (G - nb) * 8;
          convert_range(p, 0, 0, I_IN + I_SMALL, scr, gwa, NGA, lane);
          convert_range(p, 1, I_IN, I_IN + I_SMALL, scr, gwa, NGA, lane); }
      const int gw = blockIdx.x * 8 + wave, NGW = G * 8;
      convert_range(p, 2, I_IN, I_IN + I_SMALL, scr, gw, NGW, lane);
      convert_range(p, 3, I_IN, I_IN + I_SMALL, scr, gw, NGW, lane);
      if (G != 256) for (int l = 1; l < DEPTH; ++l) convert_range(p, l, 0, I_IN, scr, gw, NGW, lane); }
}

__device__ __forceinline__ void phase_u(const Params& p, int l, const float* xin, int wave, int lane, int G) {
    half_t* U = (half_t*)(p.ws + WS_U); const float* mod = (const float*)(p.ws + WS_MOD);
    const int gw = blockIdx.x * 8 + wave, NGW = G * 8;
    for (int row = gw; row < NTOK; row += NGW) {
        const f32x4* xr = (const f32x4*)(xin + (size_t)row * DM) + lane;
        f32x4 v[8]; float ss = 0.f;
#pragma unroll
        for (int j = 0; j < 8; ++j) { v[j] = xr[64 * j]; ss += (v[j][0] * v[j][0] + v[j][1] * v[j][1]) + (v[j][2] * v[j][2] + v[j][3] * v[j][3]); }
        ss = wave_sum(ss, lane);
        const float rinv = 1.0f / sqrtf(ss * (1.f / DM) + EPS);
        const float* mb = mod + (size_t)(l * 2 + (row >> 12)) * 6144;
#pragma unroll
        for (int j = 0; j < 8; ++j) { const int col = 4 * lane + 256 * j;
            const f32x4 nw = *(const f32x4*)(p.norm_w + l * DM + col), sh = *(const f32x4*)(mb + col), sc = *(const f32x4*)(mb + 2048 + col);
            const f32x4 uu = (v[j] * rinv) * nw * (sc + 1.f) + sh;
            h4 o; o[0] = op16(uu[0], INPROJ_BF16); o[1] = op16(uu[1], INPROJ_BF16); o[2] = op16(uu[2], INPROJ_BF16); o[3] = op16(uu[3], INPROJ_BF16);
            *(h4*)(U + (size_t)row * DM + col) = o; }
    }
}
__device__ __forceinline__ float load_hrow(const half_t* hrow, int lane, f32x4 (&v)[8]) {
    float ss = 0.f;
#pragma unroll
    for (int j = 0; j < 4; ++j) { const h8 x = *(const h8*)(hrow + 8 * lane + 512 * j);
        v[2 * j] = (f32x4){(float)x[0], (float)x[1], (float)x[2], (float)x[3]}; v[2 * j + 1] = (f32x4){(float)x[4], (float)x[5], (float)x[6], (float)x[7]};
        ss += (v[2 * j][0] * v[2 * j][0] + v[2 * j][1] * v[2 * j][1]) + (v[2 * j][2] * v[2 * j][2] + v[2 * j][3] * v[2 * j][3]);
        ss += (v[2 * j + 1][0] * v[2 * j + 1][0] + v[2 * j + 1][1] * v[2 * j + 1][1]) + (v[2 * j + 1][2] * v[2 * j + 1][2] + v[2 * j + 1][3] * v[2 * j + 1][3]); }
    return ss;
}
__device__ __forceinline__ void phase_u_h(const Params& p, int l, int wave, int lane, int G) {
    half_t* U = (half_t*)(p.ws + WS_U); const float* mod = (const float*)(p.ws + WS_MOD); const half_t* Hh = (const half_t*)(p.ws + WS_H);
    const int gw = blockIdx.x * 8 + wave, NGW = G * 8;
    for (int row = gw; row < NTOK; row += NGW) {
        f32x4 v[8];
        const float ss = wave_sum(load_hrow(Hh + (size_t)row * DM, lane, v), lane);
        const float rinv = 1.0f / sqrtf(ss * (1.f / DM) + EPS);
        const float* mb = mod + (size_t)(l * 2 + (row >> 12)) * 6144;
#pragma unroll
        for (int j = 0; j < 4; ++j) { const int col = 8 * lane + 512 * j;
            h8 o;
#pragma unroll
            for (int hh = 0; hh < 2; ++hh) { const int c = col + 4 * hh;
                const f32x4 nw = *(const f32x4*)(p.norm_w + l * DM + c), sh = *(const f32x4*)(mb + c), sc = *(const f32x4*)(mb + 2048 + c);
                const f32x4 uu = (v[2 * j + hh] * rinv) * nw * (sc + 1.f) + sh;
                o[4 * hh] = op16(uu[0], INPROJ_BF16); o[4 * hh + 1] = op16(uu[1], INPROJ_BF16); o[4 * hh + 2] = op16(uu[2], INPROJ_BF16); o[4 * hh + 3] = op16(uu[3], INPROJ_BF16); }
            *(h8*)(U + (size_t)row * DM + col) = o; }
    }
}
__device__ __forceinline__ void phase_final(const Params& p, int wave, int lane, int G) {
    const half_t* Hh = (const half_t*)(p.ws + WS_H);
    const int gw = blockIdx.x * 8 + wave, NGW = G * 8;
    for (int row = gw; row < NTOK; row += NGW) {
        f32x4 v[8];
        const float ss = wave_sum(load_hrow(Hh + (size_t)row * DM, lane, v), lane);
        const float rinv = 1.0f / sqrtf(ss * (1.f / DM) + EPS);
#pragma unroll
        for (int j = 0; j < 4; ++j)
#pragma unroll
            for (int hh = 0; hh < 2; ++hh) { const int c = 8 * lane + 512 * j + 4 * hh;
                const f32x4 nw = *(const f32x4*)(p.fnorm_w + c);
                *(f32x4*)(p.out + (size_t)row * DM + c) = (v[2 * j + hh] * rinv) * nw; }
    }
}

constexpr int KSTR = 136, VSTR = 272;
constexpr int RV_OFF = 128 * KSTR * 2;
template <bool ZETA>
__device__ __forceinline__ void ret_stage(const Params& p, LAS unsigned char* lds, int tb, int h, int c, float logg, int tid) {
    const half_t* PR = (const half_t*)(p.ws + WS_PROJ); const float* rot = (const float*)(p.ws + WS_ROT);
    LAS half_t* Ks = (LAS half_t*)lds; LAS half_t* Vs = (LAS half_t*)(lds + RV_OFF);
#pragma unroll
    for (int i = 0; i < 2; ++i) { const int id = tid + 512 * i, pos = id >> 3, ch = id & 7;
        const half_t* src = PR + (size_t)(tb + pos) * NIN + C_RK + h * 128 + ch * 8;
        const h8 x1 = *(const h8*)src, x2 = *(const h8*)(src + 64);
        const float* cp = rot + (size_t)(c * 128 + pos) * 64 + ch * 8; const float* sp = cp + SEQ * 64;
        const f32x4 c0 = *(const f32x4*)cp, c1 = *(const f32x4*)(cp + 4), s0 = *(const f32x4*)sp, s1 = *(const f32x4*)(sp + 4);
        float sc = 0.08838834764831845f; if (ZETA) sc *= __expf(logg * (float)(127 - pos));
        h8 y1, y2;
#pragma unroll
        for (int e = 0; e < 8; ++e) { const float co = e < 4 ? c0[e & 3] : c1[e & 3], si = e < 4 ? s0[e & 3] : s1[e & 3]; const float a = (float)x1[e], b = (float)x2[e];
            y1[e] = (half_t)((a * co - b * si) * sc); y2[e] = (half_t)((b * co + a * si) * sc); }
        *(LAS h8*)(Ks + pos * KSTR + ch * 8) = y1; *(LAS h8*)(Ks + pos * KSTR + 64 + ch * 8) = y2; }
#pragma unroll
    for (int i = 0; i < 8; ++i) { const int id = tid + 512 * i, pos = id >> 5, ch = id & 31;
        *(LAS h8*)(Vs + pos * VSTR + ch * 8) = *(const h8*)(PR + (size_t)(tb + pos) * NIN + C_RV + h * 256 + ch * 8); }
}

__device__ __forceinline__ void ret_kv_item(const Params& p, LAS unsigned char* lds, int item, int tid, int wave, int lane) {
    const int b = item >> 8, h = (item >> 5) & 7, c = item & 31, tb = b * SEQ + c * 128;
    const float logg = ret_logg(h);
    ret_stage<true>(p, lds, tb, h, c, logg, tid);
    __syncthreads();
    const LAS half_t* Ks = (const LAS half_t*)lds; const LAS half_t* Vs = (const LAS half_t*)(lds + RV_OFF);
    const int g = lane >> 4, r = lane & 15, q = (lane & 15) >> 2, pp = lane & 3;
    h8 a[4];
#pragma unroll
    for (int ks = 0; ks < 4; ++ks) { const LAS half_t* ap = Ks + (ks * 32 + g * 8 + q) * KSTR + wave * 16 + 4 * pp; a[ks] = cat8(tr_read(ap), tr_read(ap + 4 * KSTR)); }
    half_t* KV = (half_t*)(p.ws + WS_KV) + (size_t)item * 32768;
#pragma unroll 4
    for (int dvt = 0; dvt < 16; ++dvt) {
        f32x4 acc = {0.f, 0.f, 0.f, 0.f};
#pragma unroll
        for (int ks = 0; ks < 4; ++ks) { const LAS half_t* bp = Vs + (ks * 32 + g * 8 + q) * VSTR + dvt * 16 + 4 * pp; const h8 bf = cat8(tr_read(bp), tr_read(bp + 4 * VSTR));
            acc = __builtin_amdgcn_mfma_f32_16x16x32_f16(a[ks], bf, acc, 0, 0, 0); }
        h4 kvh; kvh[0] = (half_t)acc[0]; kvh[1] = (half_t)acc[1]; kvh[2] = (half_t)acc[2]; kvh[3] = (half_t)acc[3];
        *(h4*)(KV + (size_t)(((dvt * 4 + (wave >> 1)) * 64 + (((wave & 1) * 2 + (g >> 1)) * 16 + r)) * 8 + 4 * (g & 1))) = kvh;
    }
    __syncthreads();
}

__device__ __forceinline__ void phase_scan(const Params& p, int tid, int G) {
    const h4* KV = (const h4*)(p.ws + WS_KV); h4* ST = (h4*)(p.ws + WS_ST);
    for (int e4 = blockIdx.x * 512 + tid; e4 < 16 * 8192; e4 += G * 512) {
        const int bh = e4 >> 13, off = e4 & 8191; const float gch = __expf(ret_logg(bh & 7) * 128.f);
        f32x4 s = {0.f, 0.f, 0.f, 0.f};
#pragma unroll 8
        for (int c = 0; c < 31; ++c) { const h4 kvh = KV[(size_t)(bh * 32 + c) * 8192 + off]; const f32x4 kv = {(float)kvh[0], (float)kvh[1], (float)kvh[2], (float)kvh[3]}; s = s * gch + kv;
            h4 o; o[0] = (half_t)s[0]; o[1] = (half_t)s[1]; o[2] = (half_t)s[2]; o[3] = (half_t)s[3];
            ST[(size_t)(bh * 32 + c + 1) * 8192 + off] = o; }
    }
}

__device__ __forceinline__ void ret_out_item(const Params& p, int l, LAS unsigned char* lds, int item, int tid, int wave, int lane) {
    const int b = item >> 8, h = (item >> 5) & 7, c = item & 31, tb = b * SEQ + c * 128;
    const float logg = ret_logg(h);
    const half_t* PR = (const half_t*)(p.ws + WS_PROJ); const float* rot = (const float*)(p.ws + WS_ROT);
    const LAS half_t* Ks = (const LAS half_t*)lds; const LAS half_t* Vs = (const LAS half_t*)(lds + RV_OFF);
    const int g = lane >> 4, r = lane & 15, q = (lane & 15) >> 2, pp = lane & 3;
    const int ntile = wave < 4 ? wave : 11 - wave;
    const int n0 = ntile * 16, nq = n0 + r, tok = tb + nq;
    h8 xq[4]; f32x4 rc[2][2], rs[2][2];
#pragma unroll
    for (int ks = 0; ks < 4; ++ks) xq[ks] = *(const h8*)(PR + (size_t)tok * NIN + C_RQ + h * 128 + ks * 32 + g * 8);
#pragma unroll
    for (int ks = 0; ks < 2; ++ks) { const float* cp = rot + (size_t)(c * 128 + nq) * 64 + ks * 32 + g * 8; const float* sp = cp + SEQ * 64;
        rc[ks][0] = *(const f32x4*)cp; rc[ks][1] = *(const f32x4*)(cp + 4); rs[ks][0] = *(const f32x4*)sp; rs[ks][1] = *(const f32x4*)(sp + 4); }
    ret_stage<false>(p, lds, tb, h, c, logg, tid);
    h8 qf[4], qx[4];
    { const float xi = __expf(logg * (float)(nq + 1));
#pragma unroll
      for (int ks = 0; ks < 2; ++ks) {
#pragma unroll
          for (int e = 0; e < 8; ++e) { const float co = e < 4 ? rc[ks][0][e & 3] : rc[ks][1][e & 3], si = e < 4 ? rs[ks][0][e & 3] : rs[ks][1][e & 3]; const float a = (float)xq[ks][e], bb = (float)xq[ks + 2][e];
              const float y1 = a * co - bb * si, y2 = bb * co + a * si;
              qf[ks][e] = (half_t)y1; qf[ks + 2][e] = (half_t)y2; qx[ks][e] = (half_t)(y1 * xi); qx[ks + 2][e] = (half_t)(y2 * xi); } } }
    f32x4 o[16];
#pragma unroll
    for (int i = 0; i < 16; ++i) o[i] = (f32x4){0.f, 0.f, 0.f, 0.f};
    if (c > 0) {
        const half_t* Sp = (const half_t*)(p.ws + WS_ST) + (size_t)item * 32768;
#pragma unroll
        for (int dvt = 0; dvt < 16; ++dvt) {
#pragma unroll
            for (int ks = 0; ks < 4; ++ks) { const h8 af = *(const h8*)(Sp + (size_t)(((dvt * 4 + ks) * 64 + lane) * 8));
                o[dvt] = __builtin_amdgcn_mfma_f32_16x16x32_f16(af, qx[ks], o[dvt], 0, 0, 0); } }
    }
    __syncthreads();
#pragma unroll
    for (int pr = 0; pr < 4; ++pr) {
        if (2 * pr <= ntile) {
            f32x4 s0 = {0.f, 0.f, 0.f, 0.f}, s1 = {0.f, 0.f, 0.f, 0.f};
#pragma unroll
            for (int ks = 0; ks < 4; ++ks) { const h8 a0 = *(const LAS h8*)(Ks + (32 * pr + r) * KSTR + ks * 32 + g * 8), a1 = *(const LAS h8*)(Ks + (32 * pr + 16 + r) * KSTR + ks * 32 + g * 8);
                s0 = __builtin_amdgcn_mfma_f32_16x16x32_f16(a0, qf[ks], s0, 0, 0, 0); s1 = __builtin_amdgcn_mfma_f32_16x16x32_f16(a1, qf[ks], s1, 0, 0, 0); }
            h8 bp;
#pragma unroll
            for (int e = 0; e < 4; ++e) { const int d0 = nq - (32 * pr + 4 * g + e), d1 = d0 - 16;
                bp[e] = (half_t)(d0 >= 0 ? s0[e] * __expf(logg * (float)d0) : 0.f); bp[4 + e] = (half_t)(d1 >= 0 ? s1[e] * __expf(logg * (float)d1) : 0.f); }
#pragma unroll
            for (int dvt = 0; dvt < 16; ++dvt) { const LAS half_t* vp = Vs + (32 * pr + 4 * g + q) * VSTR + dvt * 16 + 4 * pp;
                const h8 af = cat8(tr_read(vp), tr_read(vp + 16 * VSTR));
                o[dvt] = __builtin_amdgcn_mfma_f32_16x16x32_f16(af, bp, o[dvt], 0, 0, 0); }
        }
    }
    float sum = 0.f;
#pragma unroll
    for (int i = 0; i < 16; ++i) sum += (o[i][0] + o[i][1]) + (o[i][2] + o[i][3]);
    sum += shx(sum, lane, 16); sum += shx(sum, lane, 32);
    const float mu = sum * (1.f / 256.f);
    float vs = 0.f;
#pragma unroll
    for (int i = 0; i < 16; ++i) { o[i] = o[i] - mu; vs += (o[i][0] * o[i][0] + o[i][1] * o[i][1]) + (o[i][2] * o[i][2] + o[i][3] * o[i][3]); }
    vs += shx(vs, lane, 16); vs += shx(vs, lane, 32);
    const float rstd = 1.0f / sqrtf(vs * (1.f / 256.f) + EPS);
    half_t* RA = (half_t*)(p.ws + WS_RA);
#pragma unroll
    for (int dvt = 0; dvt < 16; ++dvt) { const int col = h * 256 + dvt * 16 + 4 * g;
        const f32x4 gw = *(const f32x4*)(p.gn_w + l * DM + col); const h4 rg = *(const h4*)(PR + (size_t)tok * NIN + C_RG + col);
        h4 y;
#pragma unroll
        for (int e = 0; e < 4; ++e) y[e] = op16(o[dvt][e] * rstd * gw[e] * siluf((float)rg[e]), TAIL_BF16);
        *(h4*)(RA + (size_t)tok * 4096 + col) = y; }
    __syncthreads();
}

constexpr int SSTR = 72; constexpr int SV_OFF = 272 * SSTR * 2;
__device__ __forceinline__ void swa_item(const Params& p, int l, LAS unsigned char* lds, int item, int tid, int wave, int lane) {
    const int b = item >> 8, nb = (item >> 3) & 31, kvh = item & 7, tb = b * SEQ + nb * 128;
    const half_t* PR = (const half_t*)(p.ws + WS_PROJ);
    LAS half_t* Ks = (LAS half_t*)lds; LAS half_t* Vs = (LAS half_t*)(lds + SV_OFF);
    const h8 z8 = {0, 0, 0, 0, 0, 0, 0, 0};
    const int g = lane >> 4, r = lane & 15, q = (lane & 15) >> 2, pp = lane & 3;
    const int tok = tb + wave * 16 + r;
    h8 qfa[4][2];
#pragma unroll
    for (int gi = 0; gi < 4; ++gi)
#pragma unroll
        for (int ks = 0; ks < 2; ++ks) qfa[gi][ks] = *(const h8*)(PR + (size_t)tok * NIN + C_SQ + (kvh * 4 + gi) * 64 + ks * 32 + g * 8);
#pragma unroll
    for (int i = 0; i < 4; ++i) { const int id = tid + 512 * i, row = id >> 3, ch = id & 7;
        h8 kk = z8, vv = z8;
        if (nb > 0 || row >= 128) { const half_t* src = PR + (size_t)(tb - 128 + row) * NIN + kvh * 64 + ch * 8; kk = *(const h8*)(src + C_SK); vv = *(const h8*)(src + C_SV); }
        *(LAS h8*)(Ks + row * SSTR + ch * 8) = kk; *(LAS h8*)(Vs + row * SSTR + ch * 8) = vv; }
    if (tid < 128) { const int row = 256 + (tid >> 3), ch = tid & 7; *(LAS h8*)(Ks + row * SSTR + ch * 8) = z8; *(LAS h8*)(Vs + row * SSTR + ch * 8) = z8; }
    __syncthreads();
    half_t* RA = (half_t*)(p.ws + WS_RA);
#pragma unroll
    for (int gi = 0; gi < 4; ++gi) {
        const int hq = kvh * 4 + gi;
        __builtin_amdgcn_sched_barrier(0);
        h8 qf[2]; qf[0] = qfa[gi][0]; qf[1] = qfa[gi][1];
        f32x4 s[9];
#pragma unroll
        for (int t = 0; t < 9; ++t) { s[t] = (f32x4){0.f, 0.f, 0.f, 0.f};
#pragma unroll
            for (int ks = 0; ks < 2; ++ks) { const h8 a = *(const LAS h8*)(Ks + ((wave + t) * 16 + r) * SSTR + ks * 32 + g * 8);
                s[t] = __builtin_amdgcn_mfma_f32_16x16x32_f16(a, qf[ks], s[t], 0, 0, 0); } }
        const float SC2 = 0.125f * 1.44269504f;
        const float sink2 = p.sinks[l * 32 + hq] * 1.44269504f;
        const int rg4 = r - 4 * g;
        float m = sink2;
#pragma unroll
        for (int t = 0; t < 9; ++t) { const bool tile_ok = (nb > 0) || (wave + t >= 8);
#pragma unroll
            for (int e = 0; e < 4; ++e) { bool ok = tile_ok; if (t == 0) ok = ok && (rg4 < e); if (t == 8) ok = ok && (rg4 >= e);
                const float v = ok ? s[t][e] * SC2 : -INFINITY; s[t][e] = v; m = fmaxf(m, v); } }
        m = fmaxf(m, shx(m, lane, 16)); m = fmaxf(m, shx(m, lane, 32));
        float ls = 0.f;
#pragma unroll
        for (int t = 0; t < 9; ++t)
#pragma unroll
            for (int e = 0; e < 4; ++e) { const float pv = ex2(s[t][e] - m); s[t][e] = pv; ls += pv; }
        ls += shx(ls, lane, 16); ls += shx(ls, lane, 32);
        ls += ex2(sink2 - m);
        const float inv = __builtin_amdgcn_rcpf(ls);
        f32x4 o[4];
#pragma unroll
        for (int i = 0; i < 4; ++i) o[i] = (f32x4){0.f, 0.f, 0.f, 0.f};
#pragma unroll
        for (int pr = 0; pr < 5; ++pr) {
            h8 bp;
#pragma unroll
            for (int e = 0; e < 4; ++e) { bp[e] = (half_t)s[2 * pr][e]; bp[4 + e] = (pr < 4) ? (half_t)s[(pr < 4) ? 2 * pr + 1 : 0][e] : (half_t)0.f; }
#pragma unroll
            for (int mt = 0; mt < 4; ++mt) { const LAS half_t* vp = Vs + ((wave + 2 * pr) * 16 + 4 * g + q) * SSTR + mt * 16 + 4 * pp;
                const h8 af = cat8(tr_read(vp), tr_read(vp + 16 * SSTR));
                o[mt] = __builtin_amdgcn_mfma_f32_16x16x32_f16(af, bp, o[mt], 0, 0, 0); }
        }
#pragma unroll
        for (int mt = 0; mt < 4; ++mt) { const int col = hq * 64 + mt * 16 + 4 * g;
            const h4 sg = *(const h4*)(PR + (size_t)tok * NIN + C_SG + col);
            h4 y;
#pragma unroll
            for (int e = 0; e < 4; ++e) y[e] = op16(o[mt][e] * inv * siluf((float)sg[e]), TAIL_BF16);
            *(h4*)(RA + (size_t)tok * 4096 + 2048 + col) = y; }
    }
    __syncthreads();
}

#define XB_TMO      128
#define XB_XCNT(j)  (256  + 64 * (j))
#define XB_XSUB(j)  (1280 + 64 * (j))
#define XB_XGEN(j)  (2304 + 64 * (j))
#define XB_TOP      3328
#define XB_TOPGEN   3392
#define XCD_BAR_WORDS 3456
#define XB_SPIN_CAP (1u << 18)

__device__ __forceinline__ unsigned xb_ld(unsigned* p)              { return __hip_atomic_load(p, __ATOMIC_RELAXED, __HIP_MEMORY_SCOPE_AGENT); }
__device__ __forceinline__ unsigned xb_add(unsigned* p, unsigned v) { return __hip_atomic_fetch_add(p, v, __ATOMIC_RELAXED, __HIP_MEMORY_SCOPE_AGENT); }
__device__ __forceinline__ unsigned xb_xcc_id() { return (unsigned)__builtin_amdgcn_s_getreg((3 << 11) | 20) & 0xFu; }
#define XB_SPIN(cond, bar) do { unsigned _sp = 0; while (cond) { __builtin_amdgcn_s_sleep(1); \
    if ((++_sp & 255u) == 0u) { if (xb_ld(&(bar)[XB_TMO])) break; if (_sp > XB_SPIN_CAP) { atomicAdd(&(bar)[XB_TMO], 1u); break; } } } } while (0)

struct XcdBarrier {
    unsigned* bar; unsigned x;
    volatile LAS unsigned* st;
};

__device__ __forceinline__ XcdBarrier xcd_barrier_post(unsigned* bar, volatile LAS unsigned* st) {
    XcdBarrier b; b.bar = bar; b.x = xb_xcc_id(); b.st = st;
    if (threadIdx.x == 0) (void)xb_add(&bar[XB_XCNT(b.x)], 1u);
    return b;
}
__device__ __forceinline__ void xcd_barrier_complete(unsigned* bar, unsigned x, unsigned& nloc, unsigned& nx) {
    const unsigned G = gridDim.x * gridDim.y * gridDim.z;
    unsigned sum, cnt, mine, sp = 0u;
    for (;;) {
        sum = 0u; cnt = 0u; mine = 0u;
#pragma unroll
        for (unsigned j = 0; j < 16; ++j) { const unsigned c = xb_ld(&bar[XB_XCNT(j)]); sum += c; cnt += (c > 0u) ? 1u : 0u; mine = (j == x) ? c : mine; }
        if (sum == G) break;
        __builtin_amdgcn_s_sleep(1);
        if ((++sp & 255u) == 0u) { if (xb_ld(&bar[XB_TMO])) break; if (sp > XB_SPIN_CAP) { atomicAdd(&bar[XB_TMO], 1u); break; } }
    }
    nloc = mine > 0u ? mine : 1u; nx = cnt > 0u ? cnt : 1u;
}

__device__ __forceinline__ void xcd_barrier(const XcdBarrier& b) {
    asm volatile("s_waitcnt vmcnt(0)" ::: "memory");
    __syncthreads();
    if (threadIdx.x == 0) {
        unsigned* bar = b.bar;
        __builtin_amdgcn_s_waitcnt(0);
        unsigned nloc = b.st[0], nx = b.st[1];
        if (nloc == 0u) { xcd_barrier_complete(bar, b.x, nloc, nx); b.st[0] = nloc; b.st[1] = nx; }
        const unsigned old = xb_add(&bar[XB_XSUB(b.x)], 1u);
        const unsigned gen = old / nloc;
        if (old + 1u == (gen + 1u) * nloc) {
            __builtin_amdgcn_fence(__ATOMIC_RELEASE, "agent");
            asm volatile("s_waitcnt vmcnt(0)" ::: "memory");
            const unsigned og = xb_add(&bar[XB_TOP], 1u);
            const unsigned tg = og / nx;
            if (og + 1u == (tg + 1u) * nx) xb_add(&bar[XB_TOPGEN], 1u);
            else XB_SPIN(xb_ld(&bar[XB_TOPGEN]) == tg, bar);
            __builtin_amdgcn_fence(__ATOMIC_ACQUIRE, "agent");
            xb_add(&bar[XB_XGEN(b.x)], 1u);
            asm volatile("s_waitcnt vmcnt(0)" ::: "memory");
        } else {
            XB_SPIN(xb_ld(&bar[XB_XGEN(b.x)]) == gen, bar);
            __builtin_amdgcn_fence(__ATOMIC_ACQUIRE, "agent");
            asm volatile("s_waitcnt vmcnt(0)" ::: "memory");
        }
    }
    __syncthreads();
}

__global__ void __launch_bounds__(512, 2) hybrid_fwd(Params p) {
    extern __shared__ __attribute__((aligned(16))) unsigned char shm[];
    LAS unsigned char* lds = (LAS unsigned char*)shm;
    cg::grid_group grid = cg::this_grid();
    const int tid = threadIdx.x, G = gridDim.x;
    unsigned char* ws = p.ws;
    volatile LAS unsigned* ctlw = (volatile LAS unsigned*)(lds + 131072);
    if (tid < 64) ctlw[tid] = 0u;
    __syncthreads();
    const XcdBarrier xbar = xcd_barrier_post((unsigned*)(ws + WS_BAR), ctlw + 8);
#define GRID_BAR() xcd_barrier(xbar)

#define LAUNDER() int t2 = tid; asm volatile("" : "+v"(t2)); const int w2 = __builtin_amdgcn_readfirstlane(t2 >> 6), l2 = t2 & 63; (void)w2; (void)l2;
    { LAUNDER(); phase_prep(p, lds, t2, w2, l2, G); }
    if (G == 0x7fffffff) grid.sync();
    GRID_BAR();
    for (int l = 0; l < DEPTH; ++l) {
        { LAUNDER(); if (l == 0) phase_u(p, 0, p.x, w2, l2, G); else phase_u_h(p, l, w2, l2, G); }
        GRID_BAR();
        { LAUNDER();
          const bool side = (G == 256) && (l + 1 < DEPTH); const int GG = side ? 240 : G;
          if ((int)blockIdx.x < GG) {
              pg8::Gemm gm{(const half_t*)(ws + WS_U), (const half_t*)(ws + WS_WIN + l * SZ_WIN), NTOK, NIN, DM}; pg8::StaticOrder S; S.init(NTOK, NIN, GG, blockIdx.x);
              EpiProj E{(half_t*)(ws + WS_PROJ)}; pg8::gemm_phase<EpiProj>(lds, gm, S, E, t2);
          } else {
              convert_range(p, l + 1, 0, I_IN, (LAS float*)(lds + w2 * 8704), ((int)blockIdx.x - GG) * 8 + w2, (G - GG) * 8, l2);
          } }
        GRID_BAR();
        { LAUNDER(); for (int it = blockIdx.x; it < 1024; it += G) { if (it < 512) swa_item(p, l, lds, it, t2, w2, l2); else ret_kv_item(p, lds, it - 512, t2, w2, l2); } }
        GRID_BAR();
        { LAUNDER(); phase_scan(p, t2, G); }
        GRID_BAR();
        { LAUNDER(); for (int it = blockIdx.x; it < 512; it += G) ret_out_item(p, l, lds, it, t2, w2, l2); }
        GRID_BAR();
        { LAUNDER(); pg8::Gemm gm{(const half_t*)(ws + WS_RA), (const half_t*)(ws + WS_WMRG + l * SZ_WMRG), NTOK, DM, 4096}; pg8::StaticOrder S; S.init(NTOK, DM, G, blockIdx.x);
          EpiMerge E{(const half_t*)(ws + WS_PROJ), (half_t*)(ws + WS_MRG)}; pg8::gemm_phase<EpiMerge>(lds, gm, S, E, t2); }
        GRID_BAR();
        { LAUNDER(); pg8::Gemm gm{(const half_t*)(ws + WS_MRG), (const half_t*)(ws + WS_WOUT + l * SZ_WOUT), NTOK, DM, DM}; pg8::StaticOrder S; S.init(NTOK, DM, G, blockIdx.x);
          const float* gatep = (const float*)(ws + WS_MOD) + (size_t)l * 2 * 6144 + 4096;
          if (l == 0) { EpiOut<true> E{p.x, gatep, (half_t*)(ws + WS_H)}; pg8::gemm_phase<EpiOut<true>>(lds, gm, S, E, t2); }
          else { EpiOut<false> E{nullptr, gatep, (half_t*)(ws + WS_H)}; pg8::gemm_phase<EpiOut<false>>(lds, gm, S, E, t2); } }
        GRID_BAR();
    }
    { LAUNDER(); phase_final(p, w2, l2, G); }
}

extern "C" void kernel_launch(void* const* d_in, const int* in_sizes, int n_in, void* d_out, int out_size, void* d_ws, size_t ws_size, hipStream_t stream) {
    static int grid = 0;
    if (grid == 0) {
        if (n_in != 12 || out_size != NTOK * DM || ws_size < WS_END) { fprintf(stderr, "kernel_launch: unexpected shapes / workspace (%d inputs, out %d, ws %zu < %zu)\n", n_in, out_size, ws_size, (size_t)WS_END); grid = -1; return; }
        int dev = 0, cus = 0, per_cu = 0;
        (void)hipGetDevice(&dev);
        (void)hipDeviceGetAttribute(&cus, hipDeviceAttributeMultiprocessorCount, dev);
        if (hipFuncSetAttribute((const void*)hybrid_fwd, hipFuncAttributeMaxDynamicSharedMemorySize, LDS_BYTES) != hipSuccess) { fprintf(stderr, "kernel_launch: hipFuncSetAttribute failed\n"); grid = -1; return; }
        if (hipOccupancyMaxActiveBlocksPerMultiprocessor(&per_cu, (const void*)hybrid_fwd, 512, LDS_BYTES) != hipSuccess || per_cu < 1) { fprintf(stderr, "kernel_launch: occupancy query failed (%d)\n", per_cu); per_cu = 1; }
        (void)hipGetLastError();
        grid = cus * per_cu;
        fprintf(stderr, "kernel_launch: grid %d (%d CUs x %d)\n", grid, cus, per_cu);
    }
    if (grid < 0) return;
    Params p{};
    p.x = (const float*)d_in[0]; p.c = (const float*)d_in[1]; p.norm_w = (const float*)d_in[2]; p.ada_w = (const float*)d_in[3]; p.ada_b = (const float*)d_in[4];
    p.w_in = (const float*)d_in[5]; p.gn_w = (const float*)d_in[6]; p.sinks = (const float*)d_in[7]; p.w_ret_o = (const float*)d_in[8]; p.w_swa_o = (const float*)d_in[9];
    p.w_out = (const float*)d_in[10]; p.fnorm_w = (const float*)d_in[11]; p.out = (float*)d_out; p.ws = (unsigned char*)d_ws;
    if (hipMemsetAsync((unsigned char*)d_ws + WS_BAR, 0, 16384, stream) != hipSuccess) { fprintf(stderr, "kernel_launch: memset of barrier words failed\n"); return; }
    void* args[] = {&p};
    hipError_t e = hipLaunchCooperativeKernel((const void*)hybrid_fwd, dim3(grid), dim3(512), args, LDS_BYTES, stream);
    if (e != hipSuccess) fprintf(stderr, "kernel_launch: cooperative launch failed: %s (grid %d)\n", hipGetErrorString(e), grid);
}
```

```cpp
#include <hip/hip_runtime.h>
#include <hip/hip_cooperative_groups.h>
#include <cstdio>
#include <cstdint>
namespace cg = cooperative_groups;

#define LAS __attribute__((address_space(3)))
typedef _Float16 half_t;
typedef _Float16 h8 __attribute__((ext_vector_type(8)));
typedef _Float16 h4 __attribute__((ext_vector_type(4)));
typedef short s4v __attribute__((ext_vector_type(4)));
typedef float f32x4 __attribute__((ext_vector_type(4)));
typedef short s8v __attribute__((ext_vector_type(8)));
constexpr bool INPROJ_BF16 = true;
constexpr bool TAIL_BF16 = true;
__device__ __forceinline__ half_t op16(float f, bool bf) { return bf ? __builtin_bit_cast(half_t, (__bf16)f) : (half_t)f; }

constexpr int SEQ = 4096, NTOK = 8192, DM = 2048, NIN = 15360, DEPTH = 4;
constexpr int C_RQ = 0, C_RK = 1024, C_RV = 2048, C_RG = 4096, C_SQ = 6144, C_SK = 8192, C_SV = 8704, C_SG = 9216, C_MR = 11264, C_MS = 13312;
constexpr float EPS = 1e-6f;
constexpr size_t SZ_WIN = (size_t)NIN * DM * 2, SZ_WMRG = (size_t)DM * 4096 * 2, SZ_WOUT = (size_t)DM * DM * 2;
constexpr size_t WS_WIN = 0;
constexpr size_t WS_WMRG = WS_WIN + DEPTH * SZ_WIN;
constexpr size_t WS_WOUT = WS_WMRG + DEPTH * SZ_WMRG;
constexpr size_t WS_MOD = WS_WOUT + DEPTH * SZ_WOUT;
constexpr size_t WS_ROT = WS_MOD + (size_t)DEPTH * 2 * 6144 * 4;
constexpr size_t WS_U = WS_ROT + (size_t)2 * SEQ * 64 * 4;
constexpr size_t WS_PROJ = WS_U + (size_t)NTOK * DM * 2;
constexpr size_t WS_RA = WS_PROJ + (size_t)NTOK * NIN * 2;
constexpr size_t WS_MRG = WS_RA + (size_t)NTOK * 4096 * 2;
constexpr size_t WS_H = WS_MRG + (size_t)NTOK * DM * 2;
constexpr size_t WS_KV = WS_H + (size_t)NTOK * DM * 4;
constexpr size_t WS_ST = WS_KV + (size_t)512 * 32768 * 4;
constexpr size_t WS_BAR = WS_ST + (size_t)512 * 32768 * 2;
constexpr size_t WS_END = WS_BAR + 16384;
constexpr int LDS_BYTES = 131072 + 256;

struct Params {
    const float *x, *c, *norm_w, *ada_w, *ada_b, *w_in, *gn_w, *sinks, *w_ret_o, *w_swa_o, *w_out, *fnorm_w;
    float* out; unsigned char* ws;
};

namespace pg8 {
constexpr int BM = 256, BK = 64, HALF = 128, HTB = HALF * BK * 2, STAGE_BYTES = 8 * HTB, NXCD = 8, WGM = 4;
__host__ __device__ __forceinline__ int lds_byte(int r, int c) { const int st = (r >> 4) * 2 + (c >> 5), rr = r & 15, cc = c & 31, ob = rr * 64 + cc * 2; return st * 1024 + (ob ^ (((ob >> 9) & 1) << 5)); }
__host__ __device__ __forceinline__ void stage_rc(int b, int& R, int& C) { const int st = b / 1024, sb = b % 1024, swz = sb ^ (((sb >> 9) & 1) << 5); R = (st >> 1) * 16 + swz / 64; C = (st & 1) * 32 + (swz % 64) / 2; }
__host__ __device__ __forceinline__ int perm32(int rho) { const int n = rho >> 4, i = rho & 15; return 8 * (i >> 2) + 4 * n + (i & 3); }

struct Unit { int pm, pn; };
struct Gemm { const half_t* A; const half_t* Bt; int M, N, K; };

struct StaticOrder {
    int nM, nN, nwg, G, c;
    __device__ void init(int M, int N, int G_, int c_) { nM = M / BM; nN = N / BM; nwg = nM * nN; G = G_; c = c_; }
    __device__ bool next(int i, Unit& u) const {
        const long L = (long)i * G + c; if (L >= nwg) return false;
        int wgid = (int)L; { const int q = nwg / NXCD, r = nwg % NXCD, xcd = wgid % NXCD, off = wgid / NXCD; wgid = (xcd < r ? xcd * (q + 1) : r * (q + 1) + (xcd - r) * q) + off; }
        const int nig = WGM * nN, gid = wgid / nig, fm = gid * WGM, gsz = (nM - fm) < WGM ? (nM - fm) : WGM;
        u.pm = fm + ((wgid % nig) % gsz); u.pn = (wgid % nig) / gsz; return true;
    }
};

template <class Epi>
__device__ __forceinline__ void gemm_phase(LAS unsigned char* lds, const Gemm g, const StaticOrder& S, const Epi& E, const int tid) {
    const int wid = __builtin_amdgcn_readfirstlane(tid >> 6), lane = tid & 63, wr = wid >> 2, wc = wid & 3, fr = lane & 15, fq = lane >> 4;
    const int K = g.K, nt = K / BK;
    unsigned voffA[2], voffB[2];
#pragma unroll
    for (int i = 0; i < 2; ++i) { int R, C; stage_rc(tid * 16 + i * 8192, R, C); const int Rb = Epi::BJ_ADJ ? ((R >> 5) * 64 + perm32(R & 31)) : (Epi::PERM ? ((R & ~31) + perm32(R & 31)) : R);
        voffA[i] = (unsigned)(R * K + C) * 2u; voffB[i] = (unsigned)(Rb * K + C) * 2u; }
    const size_t kstep = (size_t)(BK * 2);
    const size_t hstep = (size_t)HALF * K * 2;
    const size_t tstep = 2 * hstep;
    const size_t hstepB = Epi::BJ_ADJ ? (size_t)32 * K * 2 : hstep;
    const unsigned ldsw = (unsigned)wid * 1024u;
    const int aoff = lds_byte(wr * 64 + fr, fq * 8), boff = lds_byte(wc * 32 + fr, fq * 8);
#define PG8_SA(b, h) (((b) * 2 + (h)) * HTB)
#define PG8_SB(b, h) ((4 + (b) * 2 + (h)) * HTB)
#define PG8_STAGE(bufoff, gbase, voff) do { _Pragma("unroll") for (int _i = 0; _i < 2; ++_i) \
        __builtin_amdgcn_global_load_lds((const unsigned*)((const char*)(gbase) + (voff)[_i]), (LAS unsigned*)(lds + (bufoff) + ldsw + _i * 8192), 16, 0, 0); } while (0)
#define PG8_LDA(dst, b, h) do { _Pragma("unroll") for (int m = 0; m < 4; ++m) _Pragma("unroll") for (int k = 0; k < 2; ++k) dst[m][k] = *(const LAS h8*)(lds + PG8_SA(b, h) + aoff + m * 2048 + k * 1024); } while (0)
#define PG8_LDB(dst, b, h) do { _Pragma("unroll") for (int n = 0; n < 2; ++n) _Pragma("unroll") for (int k = 0; k < 2; ++k) dst[n][k] = *(const LAS h8*)(lds + PG8_SB(b, h) + boff + n * 2048 + k * 1024); } while (0)
#define PG8_MMA(ai, bj, At, Bt) do { __builtin_amdgcn_s_setprio(1); _Pragma("unroll") for (int m = 0; m < 4; ++m) _Pragma("unroll") for (int n = 0; n < 2; ++n) _Pragma("unroll") for (int k = 0; k < 2; ++k) \
        { if constexpr (Epi::BF16) acc[ai][bj][m][n] = __builtin_amdgcn_mfma_f32_16x16x32_bf16(__builtin_bit_cast(s8v, Bt[n][k]), __builtin_bit_cast(s8v, At[m][k]), acc[ai][bj][m][n], 0, 0, 0); \
          else acc[ai][bj][m][n] = __builtin_amdgcn_mfma_f32_16x16x32_f16(Bt[n][k], At[m][k], acc[ai][bj][m][n], 0, 0, 0); } __builtin_amdgcn_s_setprio(0); } while (0)
#define PG8_WAIT_V(n) asm volatile("s_waitcnt vmcnt(" #n ")" ::: "memory")
#define PG8_WAIT_L(n) asm volatile("s_waitcnt lgkmcnt(" #n ")" ::: "memory")
#define PG8_BAR __builtin_amdgcn_s_barrier()
#define PG8_SCHED __builtin_amdgcn_sched_barrier(0)
    Unit cur, nxt; int ui = 0;
    if (!S.next(0, cur)) return;
    f32x4 acc[2][2][4][2];
#pragma unroll
    for (int a = 0; a < 2; ++a)
#pragma unroll
        for (int b = 0; b < 2; ++b)
#pragma unroll
            for (int m = 0; m < 4; ++m)
#pragma unroll
                for (int n = 0; n < 2; ++n) acc[a][b][m][n] = (f32x4){0.f, 0.f, 0.f, 0.f};
    h8 At[4][2], B0[2][2], B1[2][2];
    const char* cA = (const char*)g.A + (size_t)cur.pm * tstep; const char* cB = (const char*)g.Bt + (size_t)cur.pn * tstep;
    PG8_STAGE(PG8_SB(0, 0), cB, voffB); PG8_STAGE(PG8_SA(0, 0), cA, voffA); PG8_STAGE(PG8_SB(0, 1), cB + hstepB, voffB); PG8_STAGE(PG8_SA(0, 1), cA + hstep, voffA);
    if (wr == 1) PG8_BAR;
    PG8_WAIT_V(4); PG8_BAR;
    PG8_STAGE(PG8_SB(1, 0), cB + kstep, voffB); PG8_STAGE(PG8_SA(1, 0), cA + kstep, voffA); PG8_STAGE(PG8_SB(1, 1), cB + hstepB + kstep, voffB);
    PG8_WAIT_V(6); PG8_BAR;
    for (;;) {
        const bool has_next = S.next(ui + 1, nxt);
        const char* nA = has_next ? (const char*)g.A + (size_t)nxt.pm * tstep : cA; const char* nB = has_next ? (const char*)g.Bt + (size_t)nxt.pn * tstep : cB;
        for (int t = 0; t < nt; t += 2) {
            const bool last = (t == nt - 2);
            const char* a1 = cA + (size_t)(t + 1) * kstep;
            const char* a2 = last ? nA : cA + (size_t)(t + 2) * kstep; const char* b2 = last ? nB : cB + (size_t)(t + 2) * kstep;
            const char* a3 = a2 + kstep; const char* b3 = b2 + kstep;
            if constexpr (Epi::HAS_MID) { if (t == (nt >> 1)) E.mid(acc, cur, wr, wc, fr, fq); }
            PG8_LDB(B0, 0, 0); PG8_SCHED; PG8_LDA(At, 0, 0); PG8_STAGE(PG8_SA(1, 1), a1 + hstep, voffA);
            PG8_WAIT_L(8); PG8_BAR; PG8_WAIT_L(0); PG8_MMA(0, 0, At, B0); PG8_BAR; PG8_SCHED;
            PG8_LDB(B1, 0, 1); PG8_STAGE(PG8_SB(0, 0), b2, voffB);
            PG8_BAR; PG8_WAIT_L(0); PG8_MMA(0, 1, At, B1); PG8_BAR;
            PG8_LDA(At, 0, 1); PG8_STAGE(PG8_SA(0, 0), a2, voffA);
            PG8_BAR; PG8_WAIT_L(0); PG8_MMA(1, 0, At, B0); PG8_BAR; PG8_SCHED;
            PG8_STAGE(PG8_SB(0, 1), b2 + hstepB, voffB);
            PG8_WAIT_V(6); PG8_BAR; PG8_MMA(1, 1, At, B1); PG8_BAR;
            PG8_LDB(B0, 1, 0); PG8_SCHED; PG8_LDA(At, 1, 0); PG8_STAGE(PG8_SA(0, 1), a2 + hstep, voffA);
            PG8_WAIT_L(8); PG8_BAR; PG8_WAIT_L(0); PG8_MMA(0, 0, At, B0); PG8_BAR; PG8_SCHED;
            PG8_LDB(B1, 1, 1); PG8_STAGE(PG8_SB(1, 0), b3, voffB);
            PG8_BAR; PG8_WAIT_L(0); PG8_MMA(0, 1, At, B1); PG8_BAR;
            PG8_LDA(At, 1, 1); PG8_STAGE(PG8_SA(1, 0), a3, voffA);
            PG8_BAR; PG8_WAIT_L(0); PG8_MMA(1, 0, At, B0); PG8_BAR; PG8_SCHED;
            PG8_STAGE(PG8_SB(1, 1), b3 + hstepB, voffB);
            PG8_WAIT_V(6); PG8_BAR; PG8_MMA(1, 1, At, B1); PG8_BAR;
        }
        E(acc, cur, wr, wc, fr, fq);
        if (!has_next) break;
#pragma unroll
        for (int a = 0; a < 2; ++a)
#pragma unroll
            for (int b = 0; b < 2; ++b)
#pragma unroll
                for (int m = 0; m < 4; ++m)
#pragma unroll
                    for (int n = 0; n < 2; ++n) acc[a][b][m][n] = (f32x4){0.f, 0.f, 0.f, 0.f};
        cur = nxt; cA = nA; cB = nB; ++ui;
    }
    PG8_WAIT_V(0);
    if (wr == 0) PG8_BAR;
    PG8_BAR;
#undef PG8_SA
#undef PG8_SB
#undef PG8_STAGE
#undef PG8_LDA
#undef PG8_LDB
#undef PG8_MMA
#undef PG8_WAIT_V
#undef PG8_WAIT_L
#undef PG8_BAR
#undef PG8_SCHED
}
}

__device__ __forceinline__ float shx(float v, int lane, int m) { return __builtin_bit_cast(float, __builtin_amdgcn_ds_bpermute((lane ^ m) << 2, __builtin_bit_cast(int, v))); }
__device__ __forceinline__ float wave_sum(float v, int lane) {
#pragma unroll
    for (int o = 1; o < 64; o <<= 1) v += shx(v, lane, o);
    return v;
}
__device__ __forceinline__ float ex2(float x) { return __builtin_amdgcn_exp2f(x); }
__device__ __forceinline__ float siluf(float x) { return x * __builtin_amdgcn_rcpf(1.f + ex2(x * -1.44269504f)); }
__device__ __forceinline__ h4 tr_read(const LAS half_t* p) { s4v r = __builtin_amdgcn_ds_read_tr16_b64_v4i16((LAS s4v*)p); return __builtin_bit_cast(h4, r); }
__device__ __forceinline__ h8 cat8(h4 a, h4 b) { h8 r; r[0] = a[0]; r[1] = a[1]; r[2] = a[2]; r[3] = a[3]; r[4] = b[0]; r[5] = b[1]; r[6] = b[2]; r[7] = b[3]; return r; }
__device__ __forceinline__ float ret_logg(int h) { return log1pf(-exp2f(-5.f - (float)h)); }

struct EpiProj {
    static constexpr bool PERM = true, HAS_MID = false, BJ_ADJ = true, BF16 = INPROJ_BF16;
    half_t* O;
    typedef int i32x4 __attribute__((ext_vector_type(4)));
    __device__ __forceinline__ void mid(f32x4 (&)[2][2][4][2], const pg8::Unit&, int, int, int, int) const {}
    static __device__ __forceinline__ h8 pack8(const f32x4 v0, const f32x4 v1) { h8 o; o[0] = (half_t)v0[0]; o[1] = (half_t)v0[1]; o[2] = (half_t)v0[2]; o[3] = (half_t)v0[3]; o[4] = (half_t)v1[0]; o[5] = (half_t)v1[1]; o[6] = (half_t)v1[2]; o[7] = (half_t)v1[3]; return o; }
    __device__ __forceinline__ void operator()(f32x4 (&acc)[2][2][4][2], const pg8::Unit& u, int wr, int wc, int fr, int fq) const {
        const bool hi = fr >= 8;
        const int row0 = u.pm * 256 + wr * 64 + (fr & 7), col = u.pn * 256 + wc * 64 + fq * 8 + (hi ? 32 : 0);
#pragma unroll
        for (int ai = 0; ai < 2; ++ai)
#pragma unroll
            for (int m = 0; m < 4; ++m) {
                const h8 x0 = pack8(acc[ai][0][m][0], acc[ai][0][m][1]), x1 = pack8(acc[ai][1][m][0], acc[ai][1][m][1]);
                const i32x4 snd = hi ? __builtin_bit_cast(i32x4, x0) : __builtin_bit_cast(i32x4, x1);
                i32x4 rcv;
#pragma unroll
                for (int d = 0; d < 4; ++d) rcv[d] = __builtin_amdgcn_update_dpp(0, snd[d], 0x128  , 0xF, 0xF, false);
                const h8 rv = __builtin_bit_cast(h8, rcv);
                const h8 vA = hi ? rv : x0;
                const h8 vB = hi ? x1 : rv;
                half_t* rowp = O + (size_t)(row0 + ai * 128 + m * 16) * NIN + col;
                __builtin_nontemporal_store(vA, (h8*)rowp); __builtin_nontemporal_store(vB, (h8*)(rowp + (size_t)8 * NIN)); }
    }
};
struct EpiMerge {
    static constexpr bool PERM = true, HAS_MID = true, BJ_ADJ = false, BF16 = TAIL_BF16;
    const half_t* P; half_t* O;
    __device__ __forceinline__ void mid(f32x4 (&acc)[2][2][4][2], const pg8::Unit& u, int wr, int wc, int fr, int fq) const {
        const int row0 = u.pm * 256 + wr * 64 + fr, col0 = u.pn * 256 + wc * 32 + 8 * fq;
        unsigned base = (unsigned)(row0 * NIN + col0);
        asm volatile("" : "+v"(base));
        const half_t* bp0 = P + base;
#pragma unroll
        for (int ai = 0; ai < 2; ++ai)
#pragma unroll
            for (int m = 0; m < 4; ++m) { const half_t* rowp = bp0 + (size_t)(ai * 128 + m * 16) * NIN;
                __builtin_amdgcn_sched_barrier(0);
#pragma unroll
                for (int bj = 0; bj < 2; ++bj) { const h8 ga = *(const h8*)(rowp + C_MR + bj * 128), gb = *(const h8*)(rowp + C_MS + bj * 128);
#pragma unroll
                    for (int n = 0; n < 2; ++n)
#pragma unroll
                        for (int i = 0; i < 4; ++i) { const float a = (float)ga[4 * n + i], b = (float)gb[4 * n + i];
                            acc[ai][bj][m][n][i] *= (1.f + ex2(b * -1.44269504f)) * __builtin_amdgcn_rcpf(1.f + ex2(a * -1.44269504f)); } } }
    }
    __device__ __forceinline__ void operator()(const f32x4 (&acc)[2][2][4][2], const pg8::Unit& u, int wr, int wc, int fr, int fq) const {
        const int row0 = u.pm * 256 + wr * 64 + fr, col0 = u.pn * 256 + wc * 32 + 8 * fq;
#pragma unroll
        for (int ai = 0; ai < 2; ++ai)
#pragma unroll
            for (int m = 0; m < 4; ++m) { const size_t row = (size_t)(row0 + ai * 128 + m * 16);
#pragma unroll
                for (int bj = 0; bj < 2; ++bj) { const h8 gb = *(const h8*)(P + row * NIN + col0 + C_MS + bj * 128);
                    h8 o;
#pragma unroll
                    for (int n = 0; n < 2; ++n)
#pragma unroll
                        for (int i = 0; i < 4; ++i) o[4 * n + i] = op16(acc[ai][bj][m][n][i] * __builtin_amdgcn_rcpf(1.f + ex2((float)gb[4 * n + i] * -1.44269504f)), TAIL_BF16);
                    *(h8*)(O + row * DM + col0 + bj * 128) = o; } }
    }
};
template <bool XF32>
struct EpiOut {
    static constexpr bool PERM = true, HAS_MID = false, BJ_ADJ = false, BF16 = TAIL_BF16;
    const float* xin; const float* gate; half_t* H;
    __device__ __forceinline__ void mid(f32x4 (&)[2][2][4][2], const pg8::Unit&, int, int, int, int) const {}
    __device__ __forceinline__ void operator()(const f32x4 (&acc)[2][2][4][2], const pg8::Unit& u, int wr, int wc, int fr, int fq) const {
        const int row0 = u.pm * 256 + wr * 64 + fr, col0 = u.pn * 256 + wc * 32 + 8 * fq;
        const float* gp = gate + (size_t)((u.pm * 256) >> 12) * 6144 + col0;
        f32x4 gv[2][2];
#pragma unroll
        for (int bj = 0; bj < 2; ++bj)
#pragma unroll
            for (int n = 0; n < 2; ++n) gv[bj][n] = *(const f32x4*)(gp + bj * 128 + 4 * n);
#pragma unroll
        for (int ai = 0; ai < 2; ++ai)
#pragma unroll
            for (int m = 0; m < 4; ++m) { const size_t ro = (size_t)(row0 + ai * 128 + m * 16) * DM + col0;
#pragma unroll
                for (int bj = 0; bj < 2; ++bj) {
                    f32x4 x0, x1;
                    if (XF32) { x0 = *(const f32x4*)(xin + ro + bj * 128); x1 = *(const f32x4*)(xin + ro + bj * 128 + 4); }
                    else { const h8 xh = *(const h8*)(H + ro + bj * 128); x0 = (f32x4){(float)xh[0], (float)xh[1], (float)xh[2], (float)xh[3]}; x1 = (f32x4){(float)xh[4], (float)xh[5], (float)xh[6], (float)xh[7]}; }
                    const f32x4 y0 = x0 + gv[bj][0] * acc[ai][bj][m][0], y1 = x1 + gv[bj][1] * acc[ai][bj][m][1];
                    h8 o; o[0] = (half_t)y0[0]; o[1] = (half_t)y0[1]; o[2] = (half_t)y0[2]; o[3] = (half_t)y0[3]; o[4] = (half_t)y1[0]; o[5] = (half_t)y1[1]; o[6] = (half_t)y1[2]; o[7] = (half_t)y1[3];
                    *(h8*)(H + ro + bj * 128) = o; } }
    }
};

constexpr int I_IN = 64 * (NIN / 64), I_SQ = 64 * (DM / 64), I_SMALL = 3 * I_SQ;
struct TItem { const float* src; half_t* dst; int N, ldt; bool bf; };
__device__ __forceinline__ TItem titem(const Params& p, int l, int r, int lane) {
    const float* W; half_t* WT; int N, ldt, koff = 0;
    unsigned char* ws = p.ws;
    const bool bf = (r < I_IN) ? INPROJ_BF16 : TAIL_BF16;
    if (r < I_IN) { W = p.w_in + (size_t)l * DM * NIN; N = NIN; WT = (half_t*)(ws + WS_WIN + l * SZ_WIN); ldt = DM; }
    else { r -= I_IN; N = DM;
        if (r < I_SQ) { W = p.w_ret_o + (size_t)l * DM * DM; WT = (half_t*)(ws + WS_WMRG + l * SZ_WMRG); ldt = 4096; }
        else if (r < 2 * I_SQ) { r -= I_SQ; W = p.w_swa_o + (size_t)l * DM * DM; WT = (half_t*)(ws + WS_WMRG + l * SZ_WMRG); ldt = 4096; koff = 2048; }
        else { r -= 2 * I_SQ; W = p.w_out + (size_t)l * DM * DM; WT = (half_t*)(ws + WS_WOUT + l * SZ_WOUT); ldt = DM; } }
    const int nblk = N >> 6, kb = r / nblk, nb = r - kb * nblk, k0 = kb * 32, n0 = nb * 64;
    TItem t; t.N = N; t.ldt = ldt; t.bf = bf;
    t.src = W + (size_t)(k0 + (lane >> 4)) * N + n0 + (lane & 15) * 4;
    t.dst = WT + (size_t)(n0 + (lane >> 2)) * ldt + koff + k0 + 8 * (lane & 3);
    return t;
}
__device__ __forceinline__ void tload(const TItem& t, f32x4 (&v)[8]) {
#pragma unroll
    for (int i = 0; i < 8; ++i) v[i] = *(const f32x4*)(t.src + (size_t)(4 * i) * t.N);
}
__device__ __forceinline__ void tstore(const TItem& t, const f32x4 (&v)[8], LAS float* scr, int lane) {
    const int rr = lane >> 4, c4 = (lane & 15) * 4;
#pragma unroll
    for (int i = 0; i < 8; ++i) *(LAS f32x4*)(scr + (4 * i + rr) * 68 + c4) = v[i];
    asm volatile("s_waitcnt lgkmcnt(0)" ::: "memory");
    const int c = lane & 3;
#pragma unroll
    for (int j = 0; j < 4; ++j) { const int n = (lane >> 2) + 16 * j; const LAS float* s = scr + (8 * c) * 68 + n;
        h8 o;
#pragma unroll
        for (int e = 0; e < 8; ++e) o[e] = op16(s[e * 68], t.bf);
        *(h8*)(t.dst + (size_t)(16 * j) * t.ldt) = o; }
    asm volatile("s_waitcnt lgkmcnt(0)" ::: "memory");
}
__device__ __forceinline__ void convert_range(const Params& p, int l, int lo, int hi, LAS float* scr, int gw, int NGW, int lane) {
    int it = lo + gw;
    if (it >= hi) return;
    f32x4 cur[8], nxt[8];
    TItem tc = titem(p, l, it, lane);
    tload(tc, cur);
    for (;;) {
        const int itn = it + NGW; const bool more = itn < hi;
        TItem tn = tc;
        if (more) { tn = titem(p, l, itn, lane); tload(tn, nxt); }
        tstore(tc, cur, scr, lane);
        if (!more) break;
#pragma unroll
        for (int i = 0; i < 8; ++i) cur[i] = nxt[i];
        tc = tn; it = itn;
    }
}

__device__ __forceinline__ void phase_prep(const Params& p, LAS unsigned char* lds, int tid, int wave, int lane, int G) {
    unsigned char* ws = p.ws;
    float* mod = (float*)(ws + WS_MOD);
    for (int item = blockIdx.x; item < DEPTH * 24; item += G) {
        LAS float* cact = (LAS float*)lds; LAS float* red = (LAS float*)(lds + 16384);
        __syncthreads();
        for (int i = tid; i < 4096; i += 512) { const float cv = p.c[i]; cact[i] = cv / (1.f + expf(-cv)); }
        __syncthreads();
        const int l = item / 24, cgi = item - l * 24;
        const float* W = p.ada_w + (size_t)l * DM * 6144 + cgi * 256 + lane * 4;
        f32x4 a0 = {0.f, 0.f, 0.f, 0.f}, a1 = {0.f, 0.f, 0.f, 0.f};
        const int kb = wave * 256;
        for (int k = kb; k < kb + 256; k += 8) {
            f32x4 w[8];
#pragma unroll
            for (int i = 0; i < 8; ++i) w[i] = *(const f32x4*)(W + (size_t)(k + i) * 6144);
#pragma unroll
            for (int i = 0; i < 8; ++i) { a0 += w[i] * cact[k + i]; a1 += w[i] * cact[2048 + k + i]; }
        }
        *(LAS f32x4*)(red + (wave * 2 + 0) * 256 + lane * 4) = a0;
        *(LAS f32x4*)(red + (wave * 2 + 1) * 256 + lane * 4) = a1;
        __syncthreads();
        { const int b = tid >> 8, col = tid & 255; float s = p.ada_b[l * 6144 + cgi * 256 + col];
#pragma unroll
          for (int w = 0; w < 8; ++w) s += red[(w * 2 + b) * 256 + col];
          mod[(size_t)(l * 2 + b) * 6144 + cgi * 256 + col] = s; }
    }
    __syncthreads();
    { float* rot = (float*)(ws + WS_ROT);
      for (int idx = blockIdx.x * 512 + tid; idx < SEQ * 64; idx += G * 512) { const int pos = idx >> 6, j = idx & 63;
          const float inv = 1.0f / powf(10000.f, (float)j / 63.0f); const float ang = (float)pos * inv;
          rot[idx] = cosf(ang); rot[SEQ * 64 + idx] = sinf(ang); } }
    { LAS float* scr = (LAS float*)(lds + 32768 + wave * 8704);
      const int nb = (DEPTH * 24 < G) ? DEPTH * 24 : 0;
      if ((int)blockIdx.x >= nb) { const int gwa = ((int)blockIdx.x - nb) * 8 + wave, NGA = (G - nb) * 8;
          convert_range(p, 0, 0, I_IN + I_SMALL, scr, gwa, NGA, lane);
          convert_range(p, 1, I_IN, I_IN + I_SMALL, scr, gwa, NGA, lane); }
      const int gw = blockIdx.x * 8 + wave, NGW = G * 8;
      convert_range(p, 2, I_IN, I_IN + I_SMALL, scr, gw, NGW, lane);
      if (G != 256) convert_range(p, 3, I_IN, I_IN + I_SMALL, scr, gw, NGW, lane);
      if (G != 256) for (int l = 1; l < DEPTH; ++l) convert_range(p, l, 0, I_IN, scr, gw, NGW, lane); }
}

__device__ __forceinline__ void phase_u(const Params& p, int l, const float* xin, int wave, int lane, int G) {
    half_t* U = (half_t*)(p.ws + WS_U); const float* mod = (const float*)(p.ws + WS_MOD);
    const int gw = blockIdx.x * 8 + wave, NGW = G * 8;
    for (int row = gw; row < NTOK; row += NGW) {
        const f32x4* xr = (const f32x4*)(xin + (size_t)row * DM) + lane;
        f32x4 v[8]; float ss = 0.f;
#pragma unroll
        for (int j = 0; j < 8; ++j) { v[j] = xr[64 * j]; ss += (v[j][0] * v[j][0] + v[j][1] * v[j][1]) + (v[j][2] * v[j][2] + v[j][3] * v[j][3]); }
        ss = wave_sum(ss, lane);
        const float rinv = 1.0f / sqrtf(ss * (1.f / DM) + EPS);
        const float* mb = mod + (size_t)(l * 2 + (row >> 12)) * 6144;
#pragma unroll
        for (int j = 0; j < 8; ++j) { const int col = 4 * lane + 256 * j;
            const f32x4 nw = *(const f32x4*)(p.norm_w + l * DM + col), sh = *(const f32x4*)(mb + col), sc = *(const f32x4*)(mb + 2048 + col);
            const f32x4 uu = (v[j] * rinv) * nw * (sc + 1.f) + sh;
            h4 o; o[0] = op16(uu[0], INPROJ_BF16); o[1] = op16(uu[1], INPROJ_BF16); o[2] = op16(uu[2], INPROJ_BF16); o[3] = op16(uu[3], INPROJ_BF16);
            *(h4*)(U + (size_t)row * DM + col) = o; }
    }
}
__device__ __forceinline__ float load_hrow(const half_t* hrow, int lane, f32x4 (&v)[8]) {
    float ss = 0.f;
#pragma unroll
    for (int j = 0; j < 4; ++j) { const h8 x = *(const h8*)(hrow + 8 * lane + 512 * j);
        v[2 * j] = (f32x4){(float)x[0], (float)x[1], (float)x[2], (float)x[3]}; v[2 * j + 1] = (f32x4){(float)x[4], (float)x[5], (float)x[6], (float)x[7]};
        ss += (v[2 * j][0] * v[2 * j][0] + v[2 * j][1] * v[2 * j][1]) + (v[2 * j][2] * v[2 * j][2] + v[2 * j][3] * v[2 * j][3]);
        ss += (v[2 * j + 1][0] * v[2 * j + 1][0] + v[2 * j + 1][1] * v[2 * j + 1][1]) + (v[2 * j + 1][2] * v[2 * j + 1][2] + v[2 * j + 1][3] * v[2 * j + 1][3]); }
    return ss;
}
__device__ __forceinline__ void phase_u_h(const Params& p, int l, int wave, int lane, int G) {
    half_t* U = (half_t*)(p.ws + WS_U); const float* mod = (const float*)(p.ws + WS_MOD); const half_t* Hh = (const half_t*)(p.ws + WS_H);
    const int gw = blockIdx.x * 8 + wave, NGW = G * 8;
    for (int row = gw; row < NTOK; row += NGW) {
        f32x4 v[8];
        const float ss = wave_sum(load_hrow(Hh + (size_t)row * DM, lane, v), lane);
        const float rinv = 1.0f / sqrtf(ss * (1.f / DM) + EPS);
        const float* mb = mod + (size_t)(l * 2 + (row >> 12)) * 6144;
#pragma unroll
        for (int j = 0; j < 4; ++j) { const int col = 8 * lane + 512 * j;
            h8 o;
#pragma unroll
            for (int hh = 0; hh < 2; ++hh) { const int c = col + 4 * hh;
                const f32x4 nw = *(const f32x4*)(p.norm_w + l * DM + c), sh = *(const f32x4*)(mb + c), sc = *(const f32x4*)(mb + 2048 + c);
                const f32x4 uu = (v[2 * j + hh] * rinv) * nw * (sc + 1.f) + sh;
                o[4 * hh] = op16(uu[0], INPROJ_BF16); o[4 * hh + 1] = op16(uu[1], INPROJ_BF16); o[4 * hh + 2] = op16(uu[2], INPROJ_BF16); o[4 * hh + 3] = op16(uu[3], INPROJ_BF16); }
            *(h8*)(U + (size_t)row * DM + col) = o; }
    }
}
__device__ __forceinline__ void phase_final(const Params& p, int wave, int lane, int G) {
    const half_t* Hh = (const half_t*)(p.ws + WS_H);
    const int gw = blockIdx.x * 8 + wave, NGW = G * 8;
    for (int row = gw; row < NTOK; row += NGW) {
        f32x4 v[8];
        const float ss = wave_sum(load_hrow(Hh + (size_t)row * DM, lane, v), lane);
        const float rinv = 1.0f / sqrtf(ss * (1.f / DM) + EPS);
#pragma unroll
        for (int j = 0; j < 4; ++j)
#pragma unroll
            for (int hh = 0; hh < 2; ++hh) { const int c = 8 * lane + 512 * j + 4 * hh;
                const f32x4 nw = *(const f32x4*)(p.fnorm_w + c);
                *(f32x4*)(p.out + (size_t)row * DM + c) = (v[2 * j + hh] * rinv) * nw; }
    }
}

constexpr int KSTR = 136, VSTR = 272;
constexpr int RV_OFF = 128 * KSTR * 2;
template <bool ZETA>
__device__ __forceinline__ void ret_stage(const Params& p, LAS unsigned char* lds, int tb, int h, int c, float logg, int tid) {
    const half_t* PR = (const half_t*)(p.ws + WS_PROJ); const float* rot = (const float*)(p.ws + WS_ROT);
    LAS half_t* Ks = (LAS half_t*)lds; LAS half_t* Vs = (LAS half_t*)(lds + RV_OFF);
#pragma unroll
    for (int i = 0; i < 2; ++i) { const int id = tid + 512 * i, pos = id >> 3, ch = id & 7;
        const half_t* src = PR + (size_t)(tb + pos) * NIN + C_RK + h * 128 + ch * 8;
        const h8 x1 = *(const h8*)src, x2 = *(const h8*)(src + 64);
        const float* cp = rot + (size_t)(c * 128 + pos) * 64 + ch * 8; const float* sp = cp + SEQ * 64;
        const f32x4 c0 = *(const f32x4*)cp, c1 = *(const f32x4*)(cp + 4), s0 = *(const f32x4*)sp, s1 = *(const f32x4*)(sp + 4);
        float sc = 0.08838834764831845f; if (ZETA) sc *= __expf(logg * (float)(127 - pos));
        h8 y1, y2;
#pragma unroll
        for (int e = 0; e < 8; ++e) { const float co = e < 4 ? c0[e & 3] : c1[e & 3], si = e < 4 ? s0[e & 3] : s1[e & 3]; const float a = (float)x1[e], b = (float)x2[e];
            y1[e] = (half_t)((a * co - b * si) * sc); y2[e] = (half_t)((b * co + a * si) * sc); }
        *(LAS h8*)(Ks + pos * KSTR + ch * 8) = y1; *(LAS h8*)(Ks + pos * KSTR + 64 + ch * 8) = y2; }
#pragma unroll
    for (int i = 0; i < 8; ++i) { const int id = tid + 512 * i, pos = id >> 5, ch = id & 31;
        *(LAS h8*)(Vs + pos * VSTR + ch * 8) = *(const h8*)(PR + (size_t)(tb + pos) * NIN + C_RV + h * 256 + ch * 8); }
}

__device__ __forceinline__ void ret_kv_item(const Params& p, LAS unsigned char* lds, int item, int tid, int wave, int lane) {
    const int b = item >> 8, h = (item >> 5) & 7, c = item & 31, tb = b * SEQ + c * 128;
    const float logg = ret_logg(h);
    ret_stage<true>(p, lds, tb, h, c, logg, tid);
    __syncthreads();
    const LAS half_t* Ks = (const LAS half_t*)lds; const LAS half_t* Vs = (const LAS half_t*)(lds + RV_OFF);
    const int g = lane >> 4, r = lane & 15, q = (lane & 15) >> 2, pp = lane & 3;
    h8 a[4];
#pragma unroll
    for (int ks = 0; ks < 4; ++ks) { const LAS half_t* ap = Ks + (ks * 32 + g * 8 + q) * KSTR + wave * 16 + 4 * pp; a[ks] = cat8(tr_read(ap), tr_read(ap + 4 * KSTR)); }
    half_t* KV = (half_t*)(p.ws + WS_KV) + (size_t)item * 32768;
#pragma unroll 4
    for (int dvt = 0; dvt < 16; ++dvt) {
        f32x4 acc = {0.f, 0.f, 0.f, 0.f};
#pragma unroll
        for (int ks = 0; ks < 4; ++ks) { const LAS half_t* bp = Vs + (ks * 32 + g * 8 + q) * VSTR + dvt * 16 + 4 * pp; const h8 bf = cat8(tr_read(bp), tr_read(bp + 4 * VSTR));
            acc = __builtin_amdgcn_mfma_f32_16x16x32_f16(a[ks], bf, acc, 0, 0, 0); }
        h4 kvh; kvh[0] = (half_t)acc[0]; kvh[1] = (half_t)acc[1]; kvh[2] = (half_t)acc[2]; kvh[3] = (half_t)acc[3];
        *(h4*)(KV + (size_t)(((dvt * 4 + (wave >> 1)) * 64 + (((wave & 1) * 2 + (g >> 1)) * 16 + r)) * 8 + 4 * (g & 1))) = kvh;
    }
    __syncthreads();
}

__device__ __forceinline__ void phase_scan(const Params& p, int tid, int G) {
    const h4* KV = (const h4*)(p.ws + WS_KV); h4* ST = (h4*)(p.ws + WS_ST);
    for (int e4 = blockIdx.x * 512 + tid; e4 < 16 * 8192; e4 += G * 512) {
        const int bh = e4 >> 13, off = e4 & 8191; const float gch = __expf(ret_logg(bh & 7) * 128.f);
        f32x4 s = {0.f, 0.f, 0.f, 0.f};
#pragma unroll 8
        for (int c = 0; c < 31; ++c) { const h4 kvh = KV[(size_t)(bh * 32 + c) * 8192 + off]; const f32x4 kv = {(float)kvh[0], (float)kvh[1], (float)kvh[2], (float)kvh[3]}; s = s * gch + kv;
            h4 o; o[0] = (half_t)s[0]; o[1] = (half_t)s[1]; o[2] = (half_t)s[2]; o[3] = (half_t)s[3];
            ST[(size_t)(bh * 32 + c + 1) * 8192 + off] = o; }
    }
}

__device__ __forceinline__ void ret_out_item(const Params& p, int l, LAS unsigned char* lds, int item, int tid, int wave, int lane) {
    const int b = item >> 8, h = (item >> 5) & 7, c = item & 31, tb = b * SEQ + c * 128;
    const float logg = ret_logg(h);
    const half_t* PR = (const half_t*)(p.ws + WS_PROJ); const float* rot = (const float*)(p.ws + WS_ROT);
    const LAS half_t* Ks = (const LAS half_t*)lds; const LAS half_t* Vs = (const LAS half_t*)(lds + RV_OFF);
    const int g = lane >> 4, r = lane & 15, q = (lane & 15) >> 2, pp = lane & 3;
    const int ntile = wave < 4 ? wave : 11 - wave;
    const int n0 = ntile * 16, nq = n0 + r, tok = tb + nq;
    h8 xq[4]; f32x4 rc[2][2], rs[2][2];
#pragma unroll
    for (int ks = 0; ks < 4; ++ks) xq[ks] = *(const h8*)(PR + (size_t)tok * NIN + C_RQ + h * 128 + ks * 32 + g * 8);
#pragma unroll
    for (int ks = 0; ks < 2; ++ks) { const float* cp = rot + (size_t)(c * 128 + nq) * 64 + ks * 32 + g * 8; const float* sp = cp + SEQ * 64;
        rc[ks][0] = *(const f32x4*)cp; rc[ks][1] = *(const f32x4*)(cp + 4); rs[ks][0] = *(const f32x4*)sp; rs[ks][1] = *(const f32x4*)(sp + 4); }
    ret_stage<false>(p, lds, tb, h, c, logg, tid);
    h8 qf[4], qx[4];
    { const float xi = __expf(logg * (float)(nq + 1));
#pragma unroll
      for (int ks = 0; ks < 2; ++ks) {
#pragma unroll
          for (int e = 0; e < 8; ++e) { const float co = e < 4 ? rc[ks][0][e & 3] : rc[ks][1][e & 3], si = e < 4 ? rs[ks][0][e & 3] : rs[ks][1][e & 3]; const float a = (float)xq[ks][e], bb = (float)xq[ks + 2][e];
              const float y1 = a * co - bb * si, y2 = bb * co + a * si;
              qf[ks][e] = (half_t)y1; qf[ks + 2][e] = (half_t)y2; qx[ks][e] = (half_t)(y1 * xi); qx[ks + 2][e] = (half_t)(y2 * xi); } } }
    f32x4 o[16];
#pragma unroll
    for (int i = 0; i < 16; ++i) o[i] = (f32x4){0.f, 0.f, 0.f, 0.f};
    if (c > 0) {
        const half_t* Sp = (const half_t*)(p.ws + WS_ST) + (size_t)item * 32768;
#pragma unroll
        for (int dvt = 0; dvt < 16; ++dvt) {
#pragma unroll
            for (int ks = 0; ks < 4; ++ks) { const h8 af = *(const h8*)(Sp + (size_t)(((dvt * 4 + ks) * 64 + lane) * 8));
                o[dvt] = __builtin_amdgcn_mfma_f32_16x16x32_f16(af, qx[ks], o[dvt], 0, 0, 0); } }
    }
    __syncthreads();
#pragma unroll
    for (int pr = 0; pr < 4; ++pr) {
        if (2 * pr <= ntile) {
            f32x4 s0 = {0.f, 0.f, 0.f, 0.f}, s1 = {0.f, 0.f, 0.f, 0.f};
#pragma unroll
            for (int ks = 0; ks < 4; ++ks) { const h8 a0 = *(const LAS h8*)(Ks + (32 * pr + r) * KSTR + ks * 32 + g * 8), a1 = *(const LAS h8*)(Ks + (32 * pr + 16 + r) * KSTR + ks * 32 + g * 8);
                s0 = __builtin_amdgcn_mfma_f32_16x16x32_f16(a0, qf[ks], s0, 0, 0, 0); s1 = __builtin_amdgcn_mfma_f32_16x16x32_f16(a1, qf[ks], s1, 0, 0, 0); }
            h8 bp;
#pragma unroll
            for (int e = 0; e < 4; ++e) { const int d0 = nq - (32 * pr + 4 * g + e), d1 = d0 - 16;
                bp[e] = (half_t)(d0 >= 0 ? s0[e] * __expf(logg * (float)d0) : 0.f); bp[4 + e] = (half_t)(d1 >= 0 ? s1[e] * __expf(logg * (float)d1) : 0.f); }
#pragma unroll
            for (int dvt = 0; dvt < 16; ++dvt) { const LAS half_t* vp = Vs + (32 * pr + 4 * g + q) * VSTR + dvt * 16 + 4 * pp;
                const h8 af = cat8(tr_read(vp), tr_read(vp + 16 * VSTR));
                o[dvt] = __builtin_amdgcn_mfma_f32_16x16x32_f16(af, bp, o[dvt], 0, 0, 0); }
        }
    }
    float sum = 0.f;
#pragma unroll
    for (int i = 0; i < 16; ++i) sum += (o[i][0] + o[i][1]) + (o[i][2] + o[i][3]);
    sum += shx(sum, lane, 16); sum += shx(sum, lane, 32);
    const float mu = sum * (1.f / 256.f);
    float vs = 0.f;
#pragma unroll
    for (int i = 0; i < 16; ++i) { o[i] = o[i] - mu; vs += (o[i][0] * o[i][0] + o[i][1] * o[i][1]) + (o[i][2] * o[i][2] + o[i][3] * o[i][3]); }
    vs += shx(vs, lane, 16); vs += shx(vs, lane, 32);
    const float rstd = 1.0f / sqrtf(vs * (1.f / 256.f) + EPS);
    half_t* RA = (half_t*)(p.ws + WS_RA);
#pragma unroll
    for (int dvt = 0; dvt < 16; ++dvt) { const int col = h * 256 + dvt * 16 + 4 * g;
        const f32x4 gw = *(const f32x4*)(p.gn_w + l * DM + col); const h4 rg = *(const h4*)(PR + (size_t)tok * NIN + C_RG + col);
        h4 y;
#pragma unroll
        for (int e = 0; e < 4; ++e) y[e] = op16(o[dvt][e] * rstd * gw[e] * siluf((float)rg[e]), TAIL_BF16);
        *(h4*)(RA + (size_t)tok * 4096 + col) = y; }
    __syncthreads();
}

constexpr int SSTR = 72; constexpr int SV_OFF = 272 * SSTR * 2;
template <bool FIRST>
__device__ __forceinline__ void swa_item(const Params& p, int l, LAS unsigned char* lds, int item, int tid, int wave, int lane) {
    const int b = item >> 8, nb = (item >> 3) & 31, kvh = item & 7, tb = b * SEQ + nb * 128;
    const half_t* PR = (const half_t*)(p.ws + WS_PROJ);
    LAS half_t* Ks = (LAS half_t*)lds; LAS half_t* Vs = (LAS half_t*)(lds + SV_OFF);
    const h8 z8 = {0, 0, 0, 0, 0, 0, 0, 0};
    const int g = lane >> 4, r = lane & 15, q = (lane & 15) >> 2, pp = lane & 3;
    const int tok = tb + wave * 16 + r;
    h8 qfa[4][2];
#pragma unroll
    for (int gi = 0; gi < 4; ++gi)
#pragma unroll
        for (int ks = 0; ks < 2; ++ks) qfa[gi][ks] = *(const h8*)(PR + (size_t)tok * NIN + C_SQ + (kvh * 4 + gi) * 64 + ks * 32 + g * 8);
#pragma unroll
    for (int i = 0; i < 4; ++i) { const int id = tid + 512 * i, row = id >> 3, ch = id & 7;
        h8 kk = z8, vv = z8;
        if (nb > 0 || row >= 128) { const half_t* src = PR + (size_t)(tb - 128 + row) * NIN + kvh * 64 + ch * 8; kk = *(const h8*)(src + C_SK); vv = *(const h8*)(src + C_SV); }
        *(LAS h8*)(Ks + row * SSTR + ch * 8) = kk; *(LAS h8*)(Vs + row * SSTR + ch * 8) = vv; }
    if (tid < 128) { const int row = 256 + (tid >> 3), ch = tid & 7; *(LAS h8*)(Ks + row * SSTR + ch * 8) = z8; *(LAS h8*)(Vs + row * SSTR + ch * 8) = z8; }
    __syncthreads();
    half_t* RA = (half_t*)(p.ws + WS_RA);
#pragma unroll
    for (int gi = 0; gi < 4; ++gi) {
        const int hq = kvh * 4 + gi;
        __builtin_amdgcn_sched_barrier(0);
        h8 qf[2]; qf[0] = qfa[gi][0]; qf[1] = qfa[gi][1];
        f32x4 s[9];
#pragma unroll
        for (int t = 0; t < 9; ++t) { s[t] = (f32x4){0.f, 0.f, 0.f, 0.f};
#pragma unroll
            for (int ks = 0; ks < 2; ++ks) { const h8 a = *(const LAS h8*)(Ks + ((wave + t) * 16 + r) * SSTR + ks * 32 + g * 8);
                s[t] = __builtin_amdgcn_mfma_f32_16x16x32_f16(a, qf[ks], s[t], 0, 0, 0); } }
        const float SC2 = 0.125f * 1.44269504f;
        const float sink2 = p.sinks[l * 32 + hq] * 1.44269504f;
        const int rg4 = r - 4 * g;
#pragma unroll
        for (int e = 0; e < 4; ++e) { s[0][e] = (rg4 < e) ? s[0][e] : -INFINITY; s[8][e] = (rg4 >= e) ? s[8][e] : -INFINITY; }
        if (FIRST) {
#pragma unroll
            for (int t = 0; t < 9; ++t) { const bool tile_ok = (wave + t >= 8);
#pragma unroll
                for (int e = 0; e < 4; ++e) s[t][e] = tile_ok ? s[t][e] : -INFINITY; }
        }
        float mr = -INFINITY;
#pragma unroll
        for (int t = 0; t < 9; ++t)
#pragma unroll
            for (int e = 0; e < 4; ++e) mr = fmaxf(mr, s[t][e]);
        mr = fmaxf(mr, shx(mr, lane, 16)); mr = fmaxf(mr, shx(mr, lane, 32));
        const float m = fmaxf(mr * SC2, sink2);
        float ls = 0.f;
#pragma unroll
        for (int t = 0; t < 9; ++t)
#pragma unroll
            for (int e = 0; e < 4; ++e) { const float pv = ex2(__builtin_fmaf(s[t][e], SC2, -m)); s[t][e] = pv; ls += pv; }
        ls += shx(ls, lane, 16); ls += shx(ls, lane, 32);
        ls += ex2(sink2 - m);
        const float inv = __builtin_amdgcn_rcpf(ls);
        f32x4 o[4];
#pragma unroll
        for (int i = 0; i < 4; ++i) o[i] = (f32x4){0.f, 0.f, 0.f, 0.f};
#pragma unroll
        for (int pr = 0; pr < 5; ++pr) {
            h8 bp;
#pragma unroll
            for (int e = 0; e < 4; ++e) { bp[e] = (half_t)s[2 * pr][e]; bp[4 + e] = (pr < 4) ? (half_t)s[(pr < 4) ? 2 * pr + 1 : 0][e] : (half_t)0.f; }
#pragma unroll
            for (int mt = 0; mt < 4; ++mt) { const LAS half_t* vp = Vs + ((wave + 2 * pr) * 16 + 4 * g + q) * SSTR + mt * 16 + 4 * pp;
                const h8 af = cat8(tr_read(vp), tr_read(vp + 16 * SSTR));
                o[mt] = __builtin_amdgcn_mfma_f32_16x16x32_f16(af, bp, o[mt], 0, 0, 0); }
        }
#pragma unroll
        for (int mt = 0; mt < 4; ++mt) { const int col = hq * 64 + mt * 16 + 4 * g;
            const h4 sg = *(const h4*)(PR + (size_t)tok * NIN + C_SG + col);
            h4 y;
#pragma unroll
            for (int e = 0; e < 4; ++e) y[e] = op16(o[mt][e] * inv * siluf((float)sg[e]), TAIL_BF16);
            *(h4*)(RA + (size_t)tok * 4096 + 2048 + col) = y; }
    }
    __syncthreads();
}

#define XB_TMO      128
#define XB_XCNT(j)  (256  + 64 * (j))
#define XB_XSUB(j)  (1280 + 64 * (j))
#define XB_XGEN(j)  (2304 + 64 * (j))
#define XB_TOP      3328
#define XB_TOPGEN   3392
#define XCD_BAR_WORDS 3456
#define XB_SPIN_CAP (1u << 18)

__device__ __forceinline__ unsigned xb_ld(unsigned* p)              { return __hip_atomic_load(p, __ATOMIC_RELAXED, __HIP_MEMORY_SCOPE_AGENT); }
__device__ __forceinline__ unsigned xb_add(unsigned* p, unsigned v) { return __hip_atomic_fetch_add(p, v, __ATOMIC_RELAXED, __HIP_MEMORY_SCOPE_AGENT); }
__device__ __forceinline__ unsigned xb_xcc_id() { return (unsigned)__builtin_amdgcn_s_getreg((3 << 11) | 20) & 0xFu; }
#define XB_SPIN(cond, bar) do { unsigned _sp = 0; while (cond) { __builtin_amdgcn_s_sleep(1); \
    if ((++_sp & 255u) == 0u) { if (xb_ld(&(bar)[XB_TMO])) break; if (_sp > XB_SPIN_CAP) { atomicAdd(&(bar)[XB_TMO], 1u); break; } } } } while (0)

struct XcdBarrier {
    unsigned* bar; unsigned x;
    volatile LAS unsigned* st;
};

__device__ __forceinline__ XcdBarrier xcd_barrier_post(unsigned* bar, volatile LAS unsigned* st) {
    XcdBarrier b; b.bar = bar; b.x = xb_xcc_id(); b.st = st;
    if (threadIdx.x == 0) (void)xb_add(&bar[XB_XCNT(b.x)], 1u);
    return b;
}
__device__ __forceinline__ void xcd_barrier_complete(unsigned* bar, unsigned x, unsigned& nloc, unsigned& nx) {
    const unsigned G = gridDim.x * gridDim.y * gridDim.z;
    unsigned sum, cnt, mine, sp = 0u;
    for (;;) {
        sum = 0u; cnt = 0u; mine = 0u;
#pragma unroll
        for (unsigned j = 0; j < 16; ++j) { const unsigned c = xb_ld(&bar[XB_XCNT(j)]); sum += c; cnt += (c > 0u) ? 1u : 0u; mine = (j == x) ? c : mine; }
        if (sum == G) break;
        __builtin_amdgcn_s_sleep(1);
        if ((++sp & 255u) == 0u) { if (xb_ld(&bar[XB_TMO])) break; if (sp > XB_SPIN_CAP) { atomicAdd(&bar[XB_TMO], 1u); break; } }
    }
    nloc = mine > 0u ? mine : 1u; nx = cnt > 0u ? cnt : 1u;
}

__device__ __forceinline__ void xcd_barrier(const XcdBarrier& b) {
    asm volatile("s_waitcnt vmcnt(0)" ::: "memory");
    __syncthreads();
    if (threadIdx.x == 0) {
        unsigned* bar = b.bar;
        __builtin_amdgcn_s_waitcnt(0);
        unsigned nloc = b.st[0], nx = b.st[1];
        if (nloc == 0u) { xcd_barrier_complete(bar, b.x, nloc, nx); b.st[0] = nloc; b.st[1] = nx; }
        const unsigned old = xb_add(&bar[XB_XSUB(b.x)], 1u);
        const unsigned gen = old / nloc;
        if (old + 1u == (gen + 1u) * nloc) {
            __builtin_amdgcn_fence(__ATOMIC_RELEASE, "agent");
            asm volatile("s_waitcnt vmcnt(0)" ::: "memory");
            const unsigned og = xb_add(&bar[XB_TOP], 1u);
            const unsigned tg = og / nx;
            if (og + 1u == (tg + 1u) * nx) xb_add(&bar[XB_TOPGEN], 1u);
            else XB_SPIN(xb_ld(&bar[XB_TOPGEN]) == tg, bar);
            __builtin_amdgcn_fence(__ATOMIC_ACQUIRE, "agent");
            xb_add(&bar[XB_XGEN(b.x)], 1u);
            asm volatile("s_waitcnt vmcnt(0)" ::: "memory");
        } else {
            XB_SPIN(xb_ld(&bar[XB_XGEN(b.x)]) == gen, bar);
            __builtin_amdgcn_fence(__ATOMIC_ACQUIRE, "agent");
            asm volatile("s_waitcnt vmcnt(0)" ::: "memory");
        }
    }
    __syncthreads();
}

__global__ void __launch_bounds__(512, 2) hybrid_fwd(Params p) {
    extern __shared__ __attribute__((aligned(16))) unsigned char shm[];
    LAS unsigned char* lds = (LAS unsigned char*)shm;
    cg::grid_group grid = cg::this_grid();
    const int tid = threadIdx.x, G = gridDim.x;
    unsigned char* ws = p.ws;
    volatile LAS unsigned* ctlw = (volatile LAS unsigned*)(lds + 131072);
    if (tid < 64) ctlw[tid] = 0u;
    __syncthreads();
    const XcdBarrier xbar = xcd_barrier_post((unsigned*)(ws + WS_BAR), ctlw + 8);
#define GRID_BAR() xcd_barrier(xbar)

#define LAUNDER() int t2 = tid; asm volatile("" : "+v"(t2)); const int w2 = __builtin_amdgcn_readfirstlane(t2 >> 6), l2 = t2 & 63; (void)w2; (void)l2;
    { LAUNDER(); phase_prep(p, lds, t2, w2, l2, G); }
    if (G == 0x7fffffff) grid.sync();
    GRID_BAR();
    for (int l = 0; l < DEPTH; ++l) {
        { LAUNDER(); if (l == 0) phase_u(p, 0, p.x, w2, l2, G); else phase_u_h(p, l, w2, l2, G); }
        GRID_BAR();
        { LAUNDER();
          const bool side = (G == 256); const int GG = side ? 240 : G;
          if ((int)blockIdx.x < GG) {
              pg8::Gemm gm{(const half_t*)(ws + WS_U), (const half_t*)(ws + WS_WIN + l * SZ_WIN), NTOK, NIN, DM}; pg8::StaticOrder S; S.init(NTOK, NIN, GG, blockIdx.x);
              EpiProj E{(half_t*)(ws + WS_PROJ)}; pg8::gemm_phase<EpiProj>(lds, gm, S, E, t2);
          } else {
              if (l + 1 < DEPTH) convert_range(p, l + 1, 0, I_IN, (LAS float*)(lds + w2 * 8704), ((int)blockIdx.x - GG) * 8 + w2, (G - GG) * 8, l2);
              else convert_range(p, l, I_IN, I_IN + I_SMALL, (LAS float*)(lds + w2 * 8704), ((int)blockIdx.x - GG) * 8 + w2, (G - GG) * 8, l2);
          } }
        GRID_BAR();
        { LAUNDER(); for (int it = blockIdx.x; it < 1024; it += G) { if (it < 512) { if (((it >> 3) & 31) == 0) swa_item<true>(p, l, lds, it, t2, w2, l2); else swa_item<false>(p, l, lds, it, t2, w2, l2); } else ret_kv_item(p, lds, it - 512, t2, w2, l2); } }
        GRID_BAR();
        { LAUNDER(); phase_scan(p, t2, G); }
        GRID_BAR();
        { LAUNDER(); for (int it = blockIdx.x; it < 512; it += G) ret_out_item(p, l, lds, it, t2, w2, l2); }
        GRID_BAR();
        { LAUNDER(); pg8::Gemm gm{(const half_t*)(ws + WS_RA), (const half_t*)(ws + WS_WMRG + l * SZ_WMRG), NTOK, DM, 4096}; pg8::StaticOrder S; S.init(NTOK, DM, G, blockIdx.x);
          EpiMerge E{(const half_t*)(ws + WS_PROJ), (half_t*)(ws + WS_MRG)}; pg8::gemm_phase<EpiMerge>(lds, gm, S, E, t2); }
        GRID_BAR();
        { LAUNDER(); pg8::Gemm gm{(const half_t*)(ws + WS_MRG), (const half_t*)(ws + WS_WOUT + l * SZ_WOUT), NTOK, DM, DM}; pg8::StaticOrder S; S.init(NTOK, DM, G, blockIdx.x);
          const float* gatep = (const float*)(ws + WS_MOD) + (size_t)l * 2 * 6144 + 4096;
          if (l == 0) { EpiOut<true> E{p.x, gatep, (half_t*)(ws + WS_H)}; pg8::gemm_phase<EpiOut<true>>(lds, gm, S, E, t2); }
          else { EpiOut<false> E{nullptr, gatep, (half_t*)(ws + WS_H)}; pg8::gemm_phase<EpiOut<false>>(lds, gm, S, E, t2); } }
        GRID_BAR();
    }
    { LAUNDER(); phase_final(p, w2, l2, G); }
}

extern "C" void kernel_launch(void* const* d_in, const int* in_sizes, int n_in, void* d_out, int out_size, void* d_ws, size_t ws_size, hipStream_t stream) {
    static int grid = 0;
    if (grid == 0) {
        if (n_in != 12 || out_size != NTOK * DM || ws_size < WS_END) { fprintf(stderr, "kernel_launch: unexpected shapes / workspace (%d inputs, out %d, ws %zu < %zu)\n", n_in, out_size, ws_size, (size_t)WS_END); grid = -1; return; }
        int dev = 0, cus = 0, per_cu = 0;
        (void)hipGetDevice(&dev);
        (void)hipDeviceGetAttribute(&cus, hipDeviceAttributeMultiprocessorCount, dev);
        if (hipFuncSetAttribute((const void*)hybrid_fwd, hipFuncAttributeMaxDynamicSharedMemorySize, LDS_BYTES) != hipSuccess) { fprintf(stderr, "kernel_launch: hipFuncSetAttribute failed\n"); grid = -1; return; }
        if (hipOccupancyMaxActiveBlocksPerMultiprocessor(&per_cu, (const void*)hybrid_fwd, 512, LDS_BYTES) != hipSuccess || per_cu < 1) { fprintf(stderr, "kernel_launch: occupancy query failed (%d)\n", per_cu); per_cu = 1; }
        (void)hipGetLastError();
        grid = cus * per_cu;
        fprintf(stderr, "kernel_launch: grid %d (%d CUs x %d)\n", grid, cus, per_cu);
    }
    if (grid < 0) return;
    Params p{};
    p.x = (const float*)d_in[0]; p.c = (const float*)d_in[1]; p.norm_w = (const float*)d_in[2]; p.ada_w = (const float*)d_in[3]; p.ada_b = (const float*)d_in[4];
    p.w_in = (const float*)d_in[5]; p.gn_w = (const float*)d_in[6]; p.sinks = (const float*)d_in[7]; p.w_ret_o = (const float*)d_in[8]; p.w_swa_o = (const float*)d_in[9];
    p.w_out = (const float*)d_in[10]; p.fnorm_w = (const float*)d_in[11]; p.out = (float*)d_out; p.ws = (unsigned char*)d_ws;
    if (hipMemsetAsync((unsigned char*)d_ws + WS_BAR, 0, 16384, stream) != hipSuccess) { fprintf(stderr, "kernel_launch: memset of barrier words failed\n"); return; }
    void* args[] = {&p};
    hipError_t e = hipLaunchCooperativeKernel((const void*)hybrid_fwd, dim3(grid), dim3(512), args, LDS_BYTES, stream);
    if (e != hipSuccess) fprintf(stderr, "kernel_launch: cooperative launch failed: %s (grid %d)\n", hipGetErrorString(e), grid);
}
```

```cpp
#include <hip/hip_runtime.h>
#include <hip/hip_cooperative_groups.h>
#include <cstdio>
#include <cstdint>
namespace cg = cooperative_groups;

#define LAS __attribute__((address_space(3)))
typedef _Float16 half_t;
typedef _Float16 h8 __attribute__((ext_vector_type(8)));
typedef _Float16 h4 __attribute__((ext_vector_type(4)));
typedef short s4v __attribute__((ext_vector_type(4)));
typedef float f32x4 __attribute__((ext_vector_type(4)));
typedef short s8v __attribute__((ext_vector_type(8)));
constexpr bool INPROJ_BF16 = true;
constexpr bool TAIL_BF16 = true;
__device__ __forceinline__ half_t op16(float f, bool bf) { return bf ? __builtin_bit_cast(half_t, (__bf16)f) : (half_t)f; }

constexpr int SEQ = 4096, NTOK = 8192, DM = 2048, NIN = 15360, DEPTH = 4;
constexpr int C_RQ = 0, C_RK = 1024, C_RV = 2048, C_RG = 4096, C_SQ = 6144, C_SK = 8192, C_SV = 8704, C_SG = 9216, C_MR = 11264, C_MS = 13312;
constexpr float EPS = 1e-6f;
constexpr size_t SZ_WIN = (size_t)NIN * DM * 2, SZ_WMRG = (size_t)DM * 4096 * 2, SZ_WOUT = (size_t)DM * DM * 2;
constexpr size_t WS_WIN = 0;
constexpr size_t WS_WMRG = WS_WIN + DEPTH * SZ_WIN;
constexpr size_t WS_WOUT = WS_WMRG + DEPTH * SZ_WMRG;
constexpr size_t WS_MOD = WS_WOUT + DEPTH * SZ_WOUT;
constexpr size_t WS_ROT = WS_MOD + (size_t)DEPTH * 2 * 6144 * 4;
constexpr size_t WS_U = WS_ROT + (size_t)2 * SEQ * 64 * 4;
constexpr size_t WS_PROJ = WS_U + (size_t)NTOK * DM * 2;
constexpr size_t WS_RA = WS_PROJ + (size_t)NTOK * NIN * 2;
constexpr size_t WS_MRG = WS_RA + (size_t)NTOK * 4096 * 2;
constexpr size_t WS_H = WS_MRG + (size_t)NTOK * DM * 2;
constexpr size_t WS_KV = WS_H + (size_t)NTOK * DM * 4;
constexpr size_t WS_ST = WS_KV + (size_t)512 * 32768 * 4;
constexpr size_t WS_BAR = WS_ST + (size_t)512 * 32768 * 2;
constexpr size_t WS_END = WS_BAR + 16384;
constexpr int LDS_BYTES = 131072 + 256;

struct Params {
    const float *x, *c, *norm_w, *ada_w, *ada_b, *w_in, *gn_w, *sinks, *w_ret_o, *w_swa_o, *w_out, *fnorm_w;
    float* out; unsigned char* ws;
};

namespace pg8 {
constexpr int BM = 256, BK = 64, HALF = 128, HTB = HALF * BK * 2, STAGE_BYTES = 8 * HTB, NXCD = 8, WGM = 4;
__host__ __device__ __forceinline__ int lds_byte(int r, int c) { const int st = (r >> 4) * 2 + (c >> 5), rr = r & 15, cc = c & 31, ob = rr * 64 + cc * 2; return st * 1024 + (ob ^ (((ob >> 9) & 1) << 5)); }
__host__ __device__ __forceinline__ void stage_rc(int b, int& R, int& C) { const int st = b / 1024, sb = b % 1024, swz = sb ^ (((sb >> 9) & 1) << 5); R = (st >> 1) * 16 + swz / 64; C = (st & 1) * 32 + (swz % 64) / 2; }
__host__ __device__ __forceinline__ int perm32(int rho) { const int n = rho >> 4, i = rho & 15; return 8 * (i >> 2) + 4 * n + (i & 3); }

struct Unit { int pm, pn; };
struct Gemm { const half_t* A; const half_t* Bt; int M, N, K; };

struct StaticOrder {
    int nM, nN, nwg, G, c;
    __device__ void init(int M, int N, int G_, int c_) { nM = M / BM; nN = N / BM; nwg = nM * nN; G = G_; c = c_; }
    __device__ bool next(int i, Unit& u) const {
        const long L = (long)i * G + c; if (L >= nwg) return false;
        int wgid = (int)L; { const int q = nwg / NXCD, r = nwg % NXCD, xcd = wgid % NXCD, off = wgid / NXCD; wgid = (xcd < r ? xcd * (q + 1) : r * (q + 1) + (xcd - r) * q) + off; }
        const int nig = WGM * nN, gid = wgid / nig, fm = gid * WGM, gsz = (nM - fm) < WGM ? (nM - fm) : WGM;
        u.pm = fm + ((wgid % nig) % gsz); u.pn = (wgid % nig) / gsz; return true;
    }
};

template <class Epi>
__device__ __forceinline__ void gemm_phase(LAS unsigned char* lds, const Gemm g, const StaticOrder& S, const Epi& E, const int tid) {
    const int wid = __builtin_amdgcn_readfirstlane(tid >> 6), lane = tid & 63, wr = wid >> 2, wc = wid & 3, fr = lane & 15, fq = lane >> 4;
    const int K = g.K, nt = K / BK;
    unsigned voffA[2], voffB[2];
#pragma unroll
    for (int i = 0; i < 2; ++i) { int R, C; stage_rc(tid * 16 + i * 8192, R, C); const int Rb = Epi::BJ_ADJ ? ((R >> 5) * 64 + perm32(R & 31)) : (Epi::PERM ? ((R & ~31) + perm32(R & 31)) : R);
        voffA[i] = (unsigned)(R * K + C) * 2u; voffB[i] = (unsigned)(Rb * K + C) * 2u; }
    const size_t kstep = (size_t)(BK * 2);
    const size_t hstep = (size_t)HALF * K * 2;
    const size_t tstep = 2 * hstep;
    const size_t hstepB = Epi::BJ_ADJ ? (size_t)32 * K * 2 : hstep;
    const unsigned ldsw = (unsigned)wid * 1024u;
    const int aoff = lds_byte(wr * 64 + fr, fq * 8), boff = lds_byte(wc * 32 + fr, fq * 8);
#define PG8_SA(b, h) (((b) * 2 + (h)) * HTB)
#define PG8_SB(b, h) ((4 + (b) * 2 + (h)) * HTB)
#define PG8_STAGE(bufoff, gbase, voff) do { _Pragma("unroll") for (int _i = 0; _i < 2; ++_i) \
        __builtin_amdgcn_global_load_lds((const unsigned*)((const char*)(gbase) + (voff)[_i]), (LAS unsigned*)(lds + (bufoff) + ldsw + _i * 8192), 16, 0, 0); } while (0)
#define PG8_LDA(dst, b, h) do { _Pragma("unroll") for (int m = 0; m < 4; ++m) _Pragma("unroll") for (int k = 0; k < 2; ++k) dst[m][k] = *(const LAS h8*)(lds + PG8_SA(b, h) + aoff + m * 2048 + k * 1024); } while (0)
#define PG8_LDB(dst, b, h) do { _Pragma("unroll") for (int n = 0; n < 2; ++n) _Pragma("unroll") for (int k = 0; k < 2; ++k) dst[n][k] = *(const LAS h8*)(lds + PG8_SB(b, h) + boff + n * 2048 + k * 1024); } while (0)
#define PG8_MMA(ai, bj, At, Bt) do { __builtin_amdgcn_s_setprio(1); _Pragma("unroll") for (int m = 0; m < 4; ++m) _Pragma("unroll") for (int n = 0; n < 2; ++n) _Pragma("unroll") for (int k = 0; k < 2; ++k) \
        { if constexpr (Epi::BF16) acc[ai][bj][m][n] = __builtin_amdgcn_mfma_f32_16x16x32_bf16(__builtin_bit_cast(s8v, Bt[n][k]), __builtin_bit_cast(s8v, At[m][k]), acc[ai][bj][m][n], 0, 0, 0); \
          else acc[ai][bj][m][n] = __builtin_amdgcn_mfma_f32_16x16x32_f16(Bt[n][k], At[m][k], acc[ai][bj][m][n], 0, 0, 0); } __builtin_amdgcn_s_setprio(0); } while (0)
#define PG8_WAIT_V(n) asm volatile("s_waitcnt vmcnt(" #n ")" ::: "memory")
#define PG8_WAIT_L(n) asm volatile("s_waitcnt lgkmcnt(" #n ")" ::: "memory")
#define PG8_BAR __builtin_amdgcn_s_barrier()
#define PG8_SCHED __builtin_amdgcn_sched_barrier(0)
    Unit cur, nxt; int ui = 0;
    if (!S.next(0, cur)) return;
    f32x4 acc[2][2][4][2];
#pragma unroll
    for (int a = 0; a < 2; ++a)
#pragma unroll
        for (int b = 0; b < 2; ++b)
#pragma unroll
            for (int m = 0; m < 4; ++m)
#pragma unroll
                for (int n = 0; n < 2; ++n) acc[a][b][m][n] = (f32x4){0.f, 0.f, 0.f, 0.f};
    h8 At[4][2], B0[2][2], B1[2][2];
    const char* cA = (const char*)g.A + (size_t)cur.pm * tstep; const char* cB = (const char*)g.Bt + (size_t)cur.pn * tstep;
    PG8_STAGE(PG8_SB(0, 0), cB, voffB); PG8_STAGE(PG8_SA(0, 0), cA, voffA); PG8_STAGE(PG8_SB(0, 1), cB + hstepB, voffB); PG8_STAGE(PG8_SA(0, 1), cA + hstep, voffA);
    if (wr == 1) PG8_BAR;
    PG8_WAIT_V(4); PG8_BAR;
    PG8_STAGE(PG8_SB(1, 0), cB + kstep, voffB); PG8_STAGE(PG8_SA(1, 0), cA + kstep, voffA); PG8_STAGE(PG8_SB(1, 1), cB + hstepB + kstep, voffB);
    PG8_WAIT_V(6); PG8_BAR;
    for (;;) {
        const bool has_next = S.next(ui + 1, nxt);
        const char* nA = has_next ? (const char*)g.A + (size_t)nxt.pm * tstep : cA; const char* nB = has_next ? (const char*)g.Bt + (size_t)nxt.pn * tstep : cB;
        for (int t = 0; t < nt; t += 2) {
            const bool last = (t == nt - 2);
            const char* a1 = cA + (size_t)(t + 1) * kstep;
            const char* a2 = last ? nA : cA + (size_t)(t + 2) * kstep; const char* b2 = last ? nB : cB + (size_t)(t + 2) * kstep;
            const char* a3 = a2 + kstep; const char* b3 = b2 + kstep;
            if constexpr (Epi::HAS_MID) { if (t == (nt >> 1)) E.mid(acc, cur, wr, wc, fr, fq); }
            PG8_LDB(B0, 0, 0); PG8_SCHED; PG8_LDA(At, 0, 0); PG8_STAGE(PG8_SA(1, 1), a1 + hstep, voffA);
            PG8_WAIT_L(8); PG8_BAR; PG8_WAIT_L(0); PG8_MMA(0, 0, At, B0); PG8_BAR; PG8_SCHED;
            PG8_LDB(B1, 0, 1); PG8_STAGE(PG8_SB(0, 0), b2, voffB);
            PG8_BAR; PG8_WAIT_L(0); PG8_MMA(0, 1, At, B1); PG8_BAR;
            PG8_LDA(At, 0, 1); PG8_STAGE(PG8_SA(0, 0), a2, voffA);
            PG8_BAR; PG8_WAIT_L(0); PG8_MMA(1, 0, At, B0); PG8_BAR; PG8_SCHED;
            PG8_STAGE(PG8_SB(0, 1), b2 + hstepB, voffB);
            PG8_WAIT_V(6); PG8_BAR; PG8_MMA(1, 1, At, B1); PG8_BAR;
            PG8_LDB(B0, 1, 0); PG8_SCHED; PG8_LDA(At, 1, 0); PG8_STAGE(PG8_SA(0, 1), a2 + hstep, voffA);
            PG8_WAIT_L(8); PG8_BAR; PG8_WAIT_L(0); PG8_MMA(0, 0, At, B0); PG8_BAR; PG8_SCHED;
            PG8_LDB(B1, 1, 1); PG8_STAGE(PG8_SB(1, 0), b3, voffB);
            PG8_BAR; PG8_WAIT_L(0); PG8_MMA(0, 1, At, B1); PG8_BAR;
            PG8_LDA(At, 1, 1); PG8_STAGE(PG8_SA(1, 0), a3, voffA);
            PG8_BAR; PG8_WAIT_L(0); PG8_MMA(1, 0, At, B0); PG8_BAR; PG8_SCHED;
            PG8_STAGE(PG8_SB(1, 1), b3 + hstepB, voffB);
            PG8_WAIT_V(6); PG8_BAR; PG8_MMA(1, 1, At, B1); PG8_BAR;
        }
        E(acc, cur, wr, wc, fr, fq);
        if (!has_next) break;
#pragma unroll
        for (int a = 0; a < 2; ++a)
#pragma unroll
            for (int b = 0; b < 2; ++b)
#pragma unroll
                for (int m = 0; m < 4; ++m)
#pragma unroll
                    for (int n = 0; n < 2; ++n) acc[a][b][m][n] = (f32x4){0.f, 0.f, 0.f, 0.f};
        cur = nxt; cA = nA; cB = nB; ++ui;
    }
    PG8_WAIT_V(0);
    if (wr == 0) PG8_BAR;
    PG8_BAR;
#undef PG8_SA
#undef PG8_SB
#undef PG8_STAGE
#undef PG8_LDA
#undef PG8_LDB
#undef PG8_MMA
#undef PG8_WAIT_V
#undef PG8_WAIT_L
#undef PG8_BAR
#undef PG8_SCHED
}
}

__device__ __forceinline__ float shx(float v, int lane, int m) { return __builtin_bit_cast(float, __builtin_amdgcn_ds_bpermute((lane ^ m) << 2, __builtin_bit_cast(int, v))); }
__device__ __forceinline__ float wave_sum(float v, int lane) {
#pragma unroll
    for (int o = 1; o < 64; o <<= 1) v += shx(v, lane, o);
    return v;
}
__device__ __forceinline__ float ex2(float x) { return __builtin_amdgcn_exp2f(x); }
__device__ __forceinline__ float siluf(float x) { return x * __builtin_amdgcn_rcpf(1.f + ex2(x * -1.44269504f)); }
__device__ __forceinline__ h4 tr_read(const LAS half_t* p) { s4v r = __builtin_amdgcn_ds_read_tr16_b64_v4i16((LAS s4v*)p); return __builtin_bit_cast(h4, r); }
__device__ __forceinline__ h8 cat8(h4 a, h4 b) { h8 r; r[0] = a[0]; r[1] = a[1]; r[2] = a[2]; r[3] = a[3]; r[4] = b[0]; r[5] = b[1]; r[6] = b[2]; r[7] = b[3]; return r; }
__device__ __forceinline__ float ret_logg(int h) { return log1pf(-exp2f(-5.f - (float)h)); }

struct EpiProj {
    static constexpr bool PERM = true, HAS_MID = false, BJ_ADJ = true, BF16 = INPROJ_BF16;
    half_t* O;
    typedef int i32x4 __attribute__((ext_vector_type(4)));
    __device__ __forceinline__ void mid(f32x4 (&)[2][2][4][2], const pg8::Unit&, int, int, int, int) const {}
    static __device__ __forceinline__ h8 pack8(const f32x4 v0, const f32x4 v1) { h8 o; o[0] = (half_t)v0[0]; o[1] = (half_t)v0[1]; o[2] = (half_t)v0[2]; o[3] = (half_t)v0[3]; o[4] = (half_t)v1[0]; o[5] = (half_t)v1[1]; o[6] = (half_t)v1[2]; o[7] = (half_t)v1[3]; return o; }
    __device__ __forceinline__ void operator()(f32x4 (&acc)[2][2][4][2], const pg8::Unit& u, int wr, int wc, int fr, int fq) const {
        const bool hi = fr >= 8;
        const int row0 = u.pm * 256 + wr * 64 + (fr & 7), col = u.pn * 256 + wc * 64 + fq * 8 + (hi ? 32 : 0);
#pragma unroll
        for (int ai = 0; ai < 2; ++ai)
#pragma unroll
            for (int m = 0; m < 4; ++m) {
                const h8 x0 = pack8(acc[ai][0][m][0], acc[ai][0][m][1]), x1 = pack8(acc[ai][1][m][0], acc[ai][1][m][1]);
                const i32x4 snd = hi ? __builtin_bit_cast(i32x4, x0) : __builtin_bit_cast(i32x4, x1);
                i32x4 rcv;
#pragma unroll
                for (int d = 0; d < 4; ++d) rcv[d] = __builtin_amdgcn_update_dpp(0, snd[d], 0x128  , 0xF, 0xF, false);
                const h8 rv = __builtin_bit_cast(h8, rcv);
                const h8 vA = hi ? rv : x0;
                const h8 vB = hi ? x1 : rv;
                half_t* rowp = O + (size_t)(row0 + ai * 128 + m * 16) * NIN + col;
                __builtin_nontemporal_store(vA, (h8*)rowp); __builtin_nontemporal_store(vB, (h8*)(rowp + (size_t)8 * NIN)); }
    }
};
struct EpiMerge {
    static constexpr bool PERM = true, HAS_MID = true, BJ_ADJ = false, BF16 = TAIL_BF16;
    const half_t* P; half_t* O;
    __device__ __forceinline__ void mid(f32x4 (&acc)[2][2][4][2], const pg8::Unit& u, int wr, int wc, int fr, int fq) const {
        const int row0 = u.pm * 256 + wr * 64 + fr, col0 = u.pn * 256 + wc * 32 + 8 * fq;
        unsigned base = (unsigned)(row0 * NIN + col0);
        asm volatile("" : "+v"(base));
        const half_t* bp0 = P + base;
#pragma unroll
        for (int ai = 0; ai < 2; ++ai)
#pragma unroll
            for (int m = 0; m < 4; ++m) { const half_t* rowp = bp0 + (size_t)(ai * 128 + m * 16) * NIN;
                __builtin_amdgcn_sched_barrier(0);
#pragma unroll
                for (int bj = 0; bj < 2; ++bj) { const h8 ga = *(const h8*)(rowp + C_MR + bj * 128), gb = *(const h8*)(rowp + C_MS + bj * 128);
#pragma unroll
                    for (int n = 0; n < 2; ++n)
#pragma unroll
                        for (int i = 0; i < 4; ++i) { const float a = (float)ga[4 * n + i], b = (float)gb[4 * n + i];
                            acc[ai][bj][m][n][i] *= (1.f + ex2(b * -1.44269504f)) * __builtin_amdgcn_rcpf(1.f + ex2(a * -1.44269504f)); } } }
    }
    __device__ __forceinline__ void operator()(const f32x4 (&acc)[2][2][4][2], const pg8::Unit& u, int wr, int wc, int fr, int fq) const {
        const int row0 = u.pm * 256 + wr * 64 + fr, col0 = u.pn * 256 + wc * 32 + 8 * fq;
#pragma unroll
        for (int ai = 0; ai < 2; ++ai)
#pragma unroll
            for (int m = 0; m < 4; ++m) { const size_t row = (size_t)(row0 + ai * 128 + m * 16);
#pragma unroll
                for (int bj = 0; bj < 2; ++bj) { const h8 gb = *(const h8*)(P + row * NIN + col0 + C_MS + bj * 128);
                    h8 o;
#pragma unroll
                    for (int n = 0; n < 2; ++n)
#pragma unroll
                        for (int i = 0; i < 4; ++i) o[4 * n + i] = op16(acc[ai][bj][m][n][i] * __builtin_amdgcn_rcpf(1.f + ex2((float)gb[4 * n + i] * -1.44269504f)), TAIL_BF16);
                    *(h8*)(O + row * DM + col0 + bj * 128) = o; } }
    }
};
template <bool XF32>
struct EpiOut {
    static constexpr bool PERM = true, HAS_MID = false, BJ_ADJ = false, BF16 = TAIL_BF16;
    const float* xin; const float* gate; half_t* H;
    __device__ __forceinline__ void mid(f32x4 (&)[2][2][4][2], const pg8::Unit&, int, int, int, int) const {}
    __device__ __forceinline__ void operator()(const f32x4 (&acc)[2][2][4][2], const pg8::Unit& u, int wr, int wc, int fr, int fq) const {
        const int row0 = u.pm * 256 + wr * 64 + fr, col0 = u.pn * 256 + wc * 32 + 8 * fq;
        const float* gp = gate + (size_t)((u.pm * 256) >> 12) * 6144 + col0;
        f32x4 gv[2][2];
#pragma unroll
        for (int bj = 0; bj < 2; ++bj)
#pragma unroll
            for (int n = 0; n < 2; ++n) gv[bj][n] = *(const f32x4*)(gp + bj * 128 + 4 * n);
#pragma unroll
        for (int ai = 0; ai < 2; ++ai)
#pragma unroll
            for (int m = 0; m < 4; ++m) { const size_t ro = (size_t)(row0 + ai * 128 + m * 16) * DM + col0;
#pragma unroll
                for (int bj = 0; bj < 2; ++bj) {
                    f32x4 x0, x1;
                    if (XF32) { x0 = *(const f32x4*)(xin + ro + bj * 128); x1 = *(const f32x4*)(xin + ro + bj * 128 + 4); }
                    else { const h8 xh = *(const h8*)(H + ro + bj * 128); x0 = (f32x4){(float)xh[0], (float)xh[1], (float)xh[2], (float)xh[3]}; x1 = (f32x4){(float)xh[4], (float)xh[5], (float)xh[6], (float)xh[7]}; }
                    const f32x4 y0 = x0 + gv[bj][0] * acc[ai][bj][m][0], y1 = x1 + gv[bj][1] * acc[ai][bj][m][1];
                    h8 o; o[0] = (half_t)y0[0]; o[1] = (half_t)y0[1]; o[2] = (half_t)y0[2]; o[3] = (half_t)y0[3]; o[4] = (half_t)y1[0]; o[5] = (half_t)y1[1]; o[6] = (half_t)y1[2]; o[7] = (half_t)y1[3];
                    *(h8*)(H + ro + bj * 128) = o; } }
    }
};

constexpr int I_IN = 64 * (NIN / 64), I_SQ = 64 * (DM / 64), I_SMALL = 3 * I_SQ;
struct TItem { const float* src; half_t* dst; int N, ldt; bool bf; };
__device__ __forceinline__ TItem titem(const Params& p, int l, int r, int lane) {
    const float* W; half_t* WT; int N, ldt, koff = 0;
    unsigned char* ws = p.ws;
    const bool bf = (r < I_IN) ? INPROJ_BF16 : TAIL_BF16;
    if (r < I_IN) { W = p.w_in + (size_t)l * DM * NIN; N = NIN; WT = (half_t*)(ws + WS_WIN + l * SZ_WIN); ldt = DM; }
    else { r -= I_IN; N = DM;
        if (r < I_SQ) { W = p.w_ret_o + (size_t)l * DM * DM; WT = (half_t*)(ws + WS_WMRG + l * SZ_WMRG); ldt = 4096; }
        else if (r < 2 * I_SQ) { r -= I_SQ; W = p.w_swa_o + (size_t)l * DM * DM; WT = (half_t*)(ws + WS_WMRG + l * SZ_WMRG); ldt = 4096; koff = 2048; }
        else { r -= 2 * I_SQ; W = p.w_out + (size_t)l * DM * DM; WT = (half_t*)(ws + WS_WOUT + l * SZ_WOUT); ldt = DM; } }
    const int nblk = N >> 6, kb = r / nblk, nb = r - kb * nblk, k0 = kb * 32, n0 = nb * 64;
    TItem t; t.N = N; t.ldt = ldt; t.bf = bf;
    t.src = W + (size_t)(k0 + (lane >> 4)) * N + n0 + (lane & 15) * 4;
    t.dst = WT + (size_t)(n0 + (lane >> 2)) * ldt + koff + k0 + 8 * (lane & 3);
    return t;
}
__device__ __forceinline__ void tload(const TItem& t, f32x4 (&v)[8]) {
#pragma unroll
    for (int i = 0; i < 8; ++i) v[i] = *(const f32x4*)(t.src + (size_t)(4 * i) * t.N);
}
__device__ __forceinline__ void tstore(const TItem& t, const f32x4 (&v)[8], LAS float* scr, int lane) {
    const int rr = lane >> 4, c4 = (lane & 15) * 4;
#pragma unroll
    for (int i = 0; i < 8; ++i) { const int k = 4 * i + rr; *(LAS f32x4*)(scr + k * 68 + ((c4 + 16 * (k >> 3)) & 63)) = v[i]; }
    asm volatile("s_waitcnt lgkmcnt(0)" ::: "memory");
    const int c = lane & 3;
#pragma unroll
    for (int j = 0; j < 4; ++j) { const int n = (lane >> 2) + 16 * j; const LAS float* s = scr + (8 * c) * 68 + ((n + 16 * c) & 63);
        h8 o;
#pragma unroll
        for (int e = 0; e < 8; ++e) o[e] = op16(s[e * 68], t.bf);
        *(h8*)(t.dst + (size_t)(16 * j) * t.ldt) = o; }
    asm volatile("s_waitcnt lgkmcnt(0)" ::: "memory");
}
__device__ __forceinline__ void convert_range(const Params& p, int l, int lo, int hi, LAS float* scr, int gw, int NGW, int lane) {
    int it = lo + gw;
    if (it >= hi) return;
    f32x4 v0[8], v1[8], v2[8];
    TItem t0 = titem(p, l, it, lane), t1 = t0, t2 = t0;
    tload(t0, v0);
    if (it + NGW < hi) { t1 = titem(p, l, it + NGW, lane); tload(t1, v1); }
    for (;;) {
        const bool more1 = it + NGW < hi, more2 = it + 2 * NGW < hi;
        if (more2) { t2 = titem(p, l, it + 2 * NGW, lane); tload(t2, v2); }
        tstore(t0, v0, scr, lane);
        if (!more1) break;
#pragma unroll
        for (int i = 0; i < 8; ++i) { v0[i] = v1[i]; v1[i] = v2[i]; }
        t0 = t1; t1 = t2; it += NGW;
    }
}

__device__ __forceinline__ void phase_prep(const Params& p, LAS unsigned char* lds, int tid, int wave, int lane, int G) {
    unsigned char* ws = p.ws;
    float* mod = (float*)(ws + WS_MOD);
    for (int item = blockIdx.x; item < DEPTH * 24; item += G) {
        LAS float* cact = (LAS float*)lds; LAS float* red = (LAS float*)(lds + 16384);
        __syncthreads();
        for (int i = tid; i < 4096; i += 512) { const float cv = p.c[i]; cact[i] = cv / (1.f + expf(-cv)); }
        __syncthreads();
        const int l = item / 24, cgi = item - l * 24;
        const float* W = p.ada_w + (size_t)l * DM * 6144 + cgi * 256 + lane * 4;
        f32x4 a0 = {0.f, 0.f, 0.f, 0.f}, a1 = {0.f, 0.f, 0.f, 0.f};
        const int kb = wave * 256;
        for (int k = kb; k < kb + 256; k += 8) {
            f32x4 w[8];
#pragma unroll
            for (int i = 0; i < 8; ++i) w[i] = *(const f32x4*)(W + (size_t)(k + i) * 6144);
#pragma unroll
            for (int i = 0; i < 8; ++i) { a0 += w[i] * cact[k + i]; a1 += w[i] * cact[2048 + k + i]; }
        }
        *(LAS f32x4*)(red + (wave * 2 + 0) * 256 + lane * 4) = a0;
        *(LAS f32x4*)(red + (wave * 2 + 1) * 256 + lane * 4) = a1;
        __syncthreads();
        { const int b = tid >> 8, col = tid & 255; float s = p.ada_b[l * 6144 + cgi * 256 + col];
#pragma unroll
          for (int w = 0; w < 8; ++w) s += red[(w * 2 + b) * 256 + col];
          mod[(size_t)(l * 2 + b) * 6144 + cgi * 256 + col] = s; }
    }
    __syncthreads();
    { float* rot = (float*)(ws + WS_ROT);
      for (int idx = blockIdx.x * 512 + tid; idx < SEQ * 64; idx += G * 512) { const int pos = idx >> 6, j = idx & 63;
          const float inv = 1.0f / powf(10000.f, (float)j / 63.0f); const float ang = (float)pos * inv;
          rot[idx] = cosf(ang); rot[SEQ * 64 + idx] = sinf(ang); } }
    { LAS float* scr = (LAS float*)(lds + 32768 + wave * 8704);
      const int nb = (DEPTH * 24 < G) ? DEPTH * 24 : 0;
      if ((int)blockIdx.x >= nb) { const int gwa = ((int)blockIdx.x - nb) * 8 + wave, NGA = (G - nb) * 8;
          convert_range(p, 0, 0, I_IN + I_SMALL, scr, gwa, NGA, lane);
          convert_range(p, 1, I_IN, I_IN + I_SMALL, scr, gwa, NGA, lane); }
      const int gw = blockIdx.x * 8 + wave, NGW = G * 8;
      convert_range(p, 2, I_IN, I_IN + I_SMALL, scr, gw, NGW, lane);
      if (G != 256) convert_range(p, 3, I_IN, I_IN + I_SMALL, scr, gw, NGW, lane);
      if (G != 256) for (int l = 1; l < DEPTH; ++l) convert_range(p, l, 0, I_IN, scr, gw, NGW, lane); }
}

__device__ __forceinline__ void phase_u(const Params& p, int l, const float* xin, int wave, int lane, int G) {
    half_t* U = (half_t*)(p.ws + WS_U); const float* mod = (const float*)(p.ws + WS_MOD);
    const int gw = blockIdx.x * 8 + wave, NGW = G * 8;
    for (int row = gw; row < NTOK; row += NGW) {
        const f32x4* xr = (const f32x4*)(xin + (size_t)row * DM) + lane;
        f32x4 v[8]; float ss = 0.f;
#pragma unroll
        for (int j = 0; j < 8; ++j) { v[j] = xr[64 * j]; ss += (v[j][0] * v[j][0] + v[j][1] * v[j][1]) + (v[j][2] * v[j][2] + v[j][3] * v[j][3]); }
        ss = wave_sum(ss, lane);
        const float rinv = 1.0f / sqrtf(ss * (1.f / DM) + EPS);
        const float* mb = mod + (size_t)(l * 2 + (row >> 12)) * 6144;
#pragma unroll
        for (int j = 0; j < 8; ++j) { const int col = 4 * lane + 256 * j;
            const f32x4 nw = *(const f32x4*)(p.norm_w + l * DM + col), sh = *(const f32x4*)(mb + col), sc = *(const f32x4*)(mb + 2048 + col);
            const f32x4 uu = (v[j] * rinv) * nw * (sc + 1.f) + sh;
            h4 o; o[0] = op16(uu[0], INPROJ_BF16); o[1] = op16(uu[1], INPROJ_BF16); o[2] = op16(uu[2], INPROJ_BF16); o[3] = op16(uu[3], INPROJ_BF16);
            *(h4*)(U + (size_t)row * DM + col) = o; }
    }
}
__device__ __forceinline__ float load_hrow(const half_t* hrow, int lane, f32x4 (&v)[8]) {
    float ss = 0.f;
#pragma unroll
    for (int j = 0; j < 4; ++j) { const h8 x = *(const h8*)(hrow + 8 * lane + 512 * j);
        v[2 * j] = (f32x4){(float)x[0], (float)x[1], (float)x[2], (float)x[3]}; v[2 * j + 1] = (f32x4){(float)x[4], (float)x[5], (float)x[6], (float)x[7]};
        ss += (v[2 * j][0] * v[2 * j][0] + v[2 * j][1] * v[2 * j][1]) + (v[2 * j][2] * v[2 * j][2] + v[2 * j][3] * v[2 * j][3]);
        ss += (v[2 * j + 1][0] * v[2 * j + 1][0] + v[2 * j + 1][1] * v[2 * j + 1][1]) + (v[2 * j + 1][2] * v[2 * j + 1][2] + v[2 * j + 1][3] * v[2 * j + 1][3]); }
    return ss;
}
__device__ __forceinline__ void phase_u_h(const Params& p, int l, int wave, int lane, int G) {
    half_t* U = (half_t*)(p.ws + WS_U); const float* mod = (const float*)(p.ws + WS_MOD); const half_t* Hh = (const half_t*)(p.ws + WS_H);
    const int gw = blockIdx.x * 8 + wave, NGW = G * 8;
    for (int row = gw; row < NTOK; row += NGW) {
        f32x4 v[8];
        const float ss = wave_sum(load_hrow(Hh + (size_t)row * DM, lane, v), lane);
        const float rinv = 1.0f / sqrtf(ss * (1.f / DM) + EPS);
        const float* mb = mod + (size_t)(l * 2 + (row >> 12)) * 6144;
#pragma unroll
        for (int j = 0; j < 4; ++j) { const int col = 8 * lane + 512 * j;
            h8 o;
#pragma unroll
            for (int hh = 0; hh < 2; ++hh) { const int c = col + 4 * hh;
                const f32x4 nw = *(const f32x4*)(p.norm_w + l * DM + c), sh = *(const f32x4*)(mb + c), sc = *(const f32x4*)(mb + 2048 + c);
                const f32x4 uu = (v[2 * j + hh] * rinv) * nw * (sc + 1.f) + sh;
                o[4 * hh] = op16(uu[0], INPROJ_BF16); o[4 * hh + 1] = op16(uu[1], INPROJ_BF16); o[4 * hh + 2] = op16(uu[2], INPROJ_BF16); o[4 * hh + 3] = op16(uu[3], INPROJ_BF16); }
            *(h8*)(U + (size_t)row * DM + col) = o; }
    }
}
__device__ __forceinline__ void phase_final(const Params& p, int wave, int lane, int G) {
    const half_t* Hh = (const half_t*)(p.ws + WS_H);
    const int gw = blockIdx.x * 8 + wave, NGW = G * 8;
    for (int row = gw; row < NTOK; row += NGW) {
        f32x4 v[8];
        const float ss = wave_sum(load_hrow(Hh + (size_t)row * DM, lane, v), lane);
        const float rinv = 1.0f / sqrtf(ss * (1.f / DM) + EPS);
#pragma unroll
        for (int j = 0; j < 4; ++j)
#pragma unroll
            for (int hh = 0; hh < 2; ++hh) { const int c = 8 * lane + 512 * j + 4 * hh;
                const f32x4 nw = *(const f32x4*)(p.fnorm_w + c);
                *(f32x4*)(p.out + (size_t)row * DM + c) = (v[2 * j + hh] * rinv) * nw; }
    }
}

constexpr int KSTR = 136, VSTR = 272;
constexpr int RV_OFF = 128 * KSTR * 2;
template <bool ZETA>
__device__ __forceinline__ void ret_stage(const Params& p, LAS unsigned char* lds, int tb, int h, int c, float logg, int tid) {
    const half_t* PR = (const half_t*)(p.ws + WS_PROJ); const float* rot = (const float*)(p.ws + WS_ROT);
    LAS half_t* Ks = (LAS half_t*)lds; LAS half_t* Vs = (LAS half_t*)(lds + RV_OFF);
#pragma unroll
    for (int i = 0; i < 2; ++i) { const int id = tid + 512 * i, pos = id >> 3, ch = id & 7;
        const half_t* src = PR + (size_t)(tb + pos) * NIN + C_RK + h * 128 + ch * 8;
        const h8 x1 = *(const h8*)src, x2 = *(const h8*)(src + 64);
        const float* cp = rot + (size_t)(c * 128 + pos) * 64 + ch * 8; const float* sp = cp + SEQ * 64;
        const f32x4 c0 = *(const f32x4*)cp, c1 = *(const f32x4*)(cp + 4), s0 = *(const f32x4*)sp, s1 = *(const f32x4*)(sp + 4);
        float sc = 0.08838834764831845f; if (ZETA) sc *= __expf(logg * (float)(127 - pos));
        h8 y1, y2;
#pragma unroll
        for (int e = 0; e < 8; ++e) { const float co = e < 4 ? c0[e & 3] : c1[e & 3], si = e < 4 ? s0[e & 3] : s1[e & 3]; const float a = (float)x1[e], b = (float)x2[e];
            y1[e] = (half_t)((a * co - b * si) * sc); y2[e] = (half_t)((b * co + a * si) * sc); }
        *(LAS h8*)(Ks + pos * KSTR + ch * 8) = y1; *(LAS h8*)(Ks + pos * KSTR + 64 + ch * 8) = y2; }
#pragma unroll
    for (int i = 0; i < 8; ++i) { const int id = tid + 512 * i, pos = id >> 5, ch = id & 31;
        *(LAS h8*)(Vs + pos * VSTR + ch * 8) = *(const h8*)(PR + (size_t)(tb + pos) * NIN + C_RV + h * 256 + ch * 8); }
}

__device__ __forceinline__ void ret_kv_item(const Params& p, LAS unsigned char* lds, int item, int tid, int wave, int lane) {
    const int b = item >> 8, h = (item >> 5) & 7, c = item & 31, tb = b * SEQ + c * 128;
    const float logg = ret_logg(h);
    ret_stage<true>(p, lds, tb, h, c, logg, tid);
    __syncthreads();
    const LAS half_t* Ks = (const LAS half_t*)lds; const LAS half_t* Vs = (const LAS half_t*)(lds + RV_OFF);
    const int g = lane >> 4, r = lane & 15, q = (lane & 15) >> 2, pp = lane & 3;
    h8 a[4];
#pragma unroll
    for (int ks = 0; ks < 4; ++ks) { const LAS half_t* ap = Ks + (ks * 32 + g * 8 + q) * KSTR + wave * 16 + 4 * pp; a[ks] = cat8(tr_read(ap), tr_read(ap + 4 * KSTR)); }
    half_t* KV = (half_t*)(p.ws + WS_KV) + (size_t)item * 32768;
#pragma unroll 4
    for (int dvt = 0; dvt < 16; ++dvt) {
        f32x4 acc = {0.f, 0.f, 0.f, 0.f};
#pragma unroll
        for (int ks = 0; ks < 4; ++ks) { const LAS half_t* bp = Vs + (ks * 32 + g * 8 + q) * VSTR + dvt * 16 + 4 * pp; const h8 bf = cat8(tr_read(bp), tr_read(bp + 4 * VSTR));
            acc = __builtin_amdgcn_mfma_f32_16x16x32_f16(a[ks], bf, acc, 0, 0, 0); }
        h4 kvh; kvh[0] = (half_t)acc[0]; kvh[1] = (half_t)acc[1]; kvh[2] = (half_t)acc[2]; kvh[3] = (half_t)acc[3];
        *(h4*)(KV + (size_t)(((dvt * 4 + (wave >> 1)) * 64 + (((wave & 1) * 2 + (g >> 1)) * 16 + r)) * 8 + 4 * (g & 1))) = kvh;
    }
    __syncthreads();
}

__device__ __forceinline__ void phase_scan(const Params& p, int tid, int G) {
    const h4* KV = (const h4*)(p.ws + WS_KV); h4* ST = (h4*)(p.ws + WS_ST);
    for (int e4 = blockIdx.x * 512 + tid; e4 < 16 * 8192; e4 += G * 512) {
        const int bh = e4 >> 13, off = e4 & 8191; const float gch = __expf(ret_logg(bh & 7) * 128.f);
        f32x4 s = {0.f, 0.f, 0.f, 0.f};
#pragma unroll 8
        for (int c = 0; c < 31; ++c) { const h4 kvh = KV[(size_t)(bh * 32 + c) * 8192 + off]; const f32x4 kv = {(float)kvh[0], (float)kvh[1], (float)kvh[2], (float)kvh[3]}; s = s * gch + kv;
            h4 o; o[0] = (half_t)s[0]; o[1] = (half_t)s[1]; o[2] = (half_t)s[2]; o[3] = (half_t)s[3];
            ST[(size_t)(bh * 32 + c + 1) * 8192 + off] = o; }
    }
}

__device__ __forceinline__ void ret_out_item(const Params& p, int l, LAS unsigned char* lds, int item, int tid, int wave, int lane) {
    const int b = item >> 8, h = (item >> 5) & 7, c = item & 31, tb = b * SEQ + c * 128;
    const float logg = ret_logg(h);
    const half_t* PR = (const half_t*)(p.ws + WS_PROJ); const float* rot = (const float*)(p.ws + WS_ROT);
    const LAS half_t* Ks = (const LAS half_t*)lds; const LAS half_t* Vs = (const LAS half_t*)(lds + RV_OFF);
    const int g = lane >> 4, r = lane & 15, q = (lane & 15) >> 2, pp = lane & 3;
    const int ntile = wave < 4 ? wave : 11 - wave;
    const int n0 = ntile * 16, nq = n0 + r, tok = tb + nq;
    h8 xq[4]; f32x4 rc[2][2], rs[2][2];
#pragma unroll
    for (int ks = 0; ks < 4; ++ks) xq[ks] = *(const h8*)(PR + (size_t)tok * NIN + C_RQ + h * 128 + ks * 32 + g * 8);
#pragma unroll
    for (int ks = 0; ks < 2; ++ks) { const float* cp = rot + (size_t)(c * 128 + nq) * 64 + ks * 32 + g * 8; const float* sp = cp + SEQ * 64;
        rc[ks][0] = *(const f32x4*)cp; rc[ks][1] = *(const f32x4*)(cp + 4); rs[ks][0] = *(const f32x4*)sp; rs[ks][1] = *(const f32x4*)(sp + 4); }
    ret_stage<false>(p, lds, tb, h, c, logg, tid);
    h8 qf[4], qx[4];
    { const float xi = __expf(logg * (float)(nq + 1));
#pragma unroll
      for (int ks = 0; ks < 2; ++ks) {
#pragma unroll
          for (int e = 0; e < 8; ++e) { const float co = e < 4 ? rc[ks][0][e & 3] : rc[ks][1][e & 3], si = e < 4 ? rs[ks][0][e & 3] : rs[ks][1][e & 3]; const float a = (float)xq[ks][e], bb = (float)xq[ks + 2][e];
              const float y1 = a * co - bb * si, y2 = bb * co + a * si;
              qf[ks][e] = (half_t)y1; qf[ks + 2][e] = (half_t)y2; qx[ks][e] = (half_t)(y1 * xi); qx[ks + 2][e] = (half_t)(y2 * xi); } } }
    f32x4 o[16];
#pragma unroll
    for (int i = 0; i < 16; ++i) o[i] = (f32x4){0.f, 0.f, 0.f, 0.f};
    if (c > 0) {
        const half_t* Sp = (const half_t*)(p.ws + WS_ST) + (size_t)item * 32768;
#pragma unroll
        for (int dvt = 0; dvt < 16; ++dvt) {
#pragma unroll
            for (int ks = 0; ks < 4; ++ks) { const h8 af = *(const h8*)(Sp + (size_t)(((dvt * 4 + ks) * 64 + lane) * 8));
                o[dvt] = __builtin_amdgcn_mfma_f32_16x16x32_f16(af, qx[ks], o[dvt], 0, 0, 0); } }
    }
    __syncthreads();
#pragma unroll
    for (int pr = 0; pr < 4; ++pr) {
        if (2 * pr <= ntile) {
            f32x4 s0 = {0.f, 0.f, 0.f, 0.f}, s1 = {0.f, 0.f, 0.f, 0.f};
#pragma unroll
            for (int ks = 0; ks < 4; ++ks) { const h8 a0 = *(const LAS h8*)(Ks + (32 * pr + r) * KSTR + ks * 32 + g * 8), a1 = *(const LAS h8*)(Ks + (32 * pr + 16 + r) * KSTR + ks * 32 + g * 8);
                s0 = __builtin_amdgcn_mfma_f32_16x16x32_f16(a0, qf[ks], s0, 0, 0, 0); s1 = __builtin_amdgcn_mfma_f32_16x16x32_f16(a1, qf[ks], s1, 0, 0, 0); }
            h8 bp;
#pragma unroll
            for (int e = 0; e < 4; ++e) { const int d0 = nq - (32 * pr + 4 * g + e), d1 = d0 - 16;
                bp[e] = (half_t)(d0 >= 0 ? s0[e] * __expf(logg * (float)d0) : 0.f); bp[4 + e] = (half_t)(d1 >= 0 ? s1[e] * __expf(logg * (float)d1) : 0.f); }
#pragma unroll
            for (int dvt = 0; dvt < 16; ++dvt) { const LAS half_t* vp = Vs + (32 * pr + 4 * g + q) * VSTR + dvt * 16 + 4 * pp;
                const h8 af = cat8(tr_read(vp), tr_read(vp + 16 * VSTR));
                o[dvt] = __builtin_amdgcn_mfma_f32_16x16x32_f16(af, bp, o[dvt], 0, 0, 0); }
        }
    }
    float sum = 0.f;
#pragma unroll
    for (int i = 0; i < 16; ++i) sum += (o[i][0] + o[i][1]) + (o[i][2] + o[i][3]);
    sum += shx(sum, lane, 16); sum += shx(sum, lane, 32);
    const float mu = sum * (1.f / 256.f);
    float vs = 0.f;
#pragma unroll
    for (int i = 0; i < 16; ++i) { o[i] = o[i] - mu; vs += (o[i][0] * o[i][0] + o[i][1] * o[i][1]) + (o[i][2] * o[i][2] + o[i][3] * o[i][3]); }
    vs += shx(vs, lane, 16); vs += shx(vs, lane, 32);
    const float rstd = 1.0f / sqrtf(vs * (1.f / 256.f) + EPS);
    half_t* RA = (half_t*)(p.ws + WS_RA);
#pragma unroll
    for (int dvt = 0; dvt < 16; ++dvt) { const int col = h * 256 + dvt * 16 + 4 * g;
        const f32x4 gw = *(const f32x4*)(p.gn_w + l * DM + col); const h4 rg = *(const h4*)(PR + (size_t)tok * NIN + C_RG + col);
        h4 y;
#pragma unroll
        for (int e = 0; e < 4; ++e) y[e] = op16(o[dvt][e] * rstd * gw[e] * siluf((float)rg[e]), TAIL_BF16);
        *(h4*)(RA + (size_t)tok * 4096 + col) = y; }
    __syncthreads();
}

constexpr int SSTR = 72; constexpr int SV_OFF = 272 * SSTR * 2;
template <bool FIRST>
__device__ __forceinline__ void swa_item(const Params& p, int l, LAS unsigned char* lds, int item, int tid, int wave, int lane) {
    const int b = item >> 8, nb = (item >> 3) & 31, kvh = item & 7, tb = b * SEQ + nb * 128;
    const half_t* PR = (const half_t*)(p.ws + WS_PROJ);
    LAS half_t* Ks = (LAS half_t*)lds; LAS half_t* Vs = (LAS half_t*)(lds + SV_OFF);
    const h8 z8 = {0, 0, 0, 0, 0, 0, 0, 0};
    const int g = lane >> 4, r = lane & 15, q = (lane & 15) >> 2, pp = lane & 3;
    const int tok = tb + wave * 16 + r;
    h8 qfa[4][2];
#pragma unroll
    for (int gi = 0; gi < 4; ++gi)
#pragma unroll
        for (int ks = 0; ks < 2; ++ks) qfa[gi][ks] = *(const h8*)(PR + (size_t)tok * NIN + C_SQ + (kvh * 4 + gi) * 64 + ks * 32 + g * 8);
#pragma unroll
    for (int i = 0; i < 4; ++i) { const int id = tid + 512 * i, row = id >> 3, ch = id & 7;
        h8 kk = z8, vv = z8;
        if (nb > 0 || row >= 128) { const half_t* src = PR + (size_t)(tb - 128 + row) * NIN + kvh * 64 + ch * 8; kk = *(const h8*)(src + C_SK); vv = *(const h8*)(src + C_SV); }
        *(LAS h8*)(Ks + row * SSTR + ch * 8) = kk; *(LAS h8*)(Vs + row * SSTR + ch * 8) = vv; }
    if (tid < 128) { const int row = 256 + (tid >> 3), ch = tid & 7; *(LAS h8*)(Ks + row * SSTR + ch * 8) = z8; *(LAS h8*)(Vs + row * SSTR + ch * 8) = z8; }
    __syncthreads();
    half_t* RA = (half_t*)(p.ws + WS_RA);
#pragma unroll
    for (int gi = 0; gi < 4; ++gi) {
        const int hq = kvh * 4 + gi;
        __builtin_amdgcn_sched_barrier(0);
        h8 qf[2]; qf[0] = qfa[gi][0]; qf[1] = qfa[gi][1];
        f32x4 s[9];
#pragma unroll
        for (int t = 0; t < 9; ++t) { s[t] = (f32x4){0.f, 0.f, 0.f, 0.f};
#pragma unroll
            for (int ks = 0; ks < 2; ++ks) { const h8 a = *(const LAS h8*)(Ks + ((wave + t) * 16 + r) * SSTR + ks * 32 + g * 8);
                s[t] = __builtin_amdgcn_mfma_f32_16x16x32_f16(a, qf[ks], s[t], 0, 0, 0); } }
        const float SC2 = 0.125f * 1.44269504f;
        const float sink2 = p.sinks[l * 32 + hq] * 1.44269504f;
        const int rg4 = r - 4 * g;
#pragma unroll
        for (int e = 0; e < 4; ++e) { s[0][e] = (rg4 < e) ? s[0][e] : -INFINITY; s[8][e] = (rg4 >= e) ? s[8][e] : -INFINITY; }
        if (FIRST) {
#pragma unroll
            for (int t = 0; t < 9; ++t) { const bool tile_ok = (wave + t >= 8);
#pragma unroll
                for (int e = 0; e < 4; ++e) s[t][e] = tile_ok ? s[t][e] : -INFINITY; }
        }
        float mr = -INFINITY;
#pragma unroll
        for (int t = 0; t < 9; ++t)
#pragma unroll
            for (int e = 0; e < 4; ++e) mr = fmaxf(mr, s[t][e]);
        mr = fmaxf(mr, shx(mr, lane, 16)); mr = fmaxf(mr, shx(mr, lane, 32));
        const float m = fmaxf(mr * SC2, sink2);
        float ls = 0.f;
#pragma unroll
        for (int t = 0; t < 9; ++t)
#pragma unroll
            for (int e = 0; e < 4; ++e) { const float pv = ex2(__builtin_fmaf(s[t][e], SC2, -m)); s[t][e] = pv; ls += pv; }
        ls += shx(ls, lane, 16); ls += shx(ls, lane, 32);
        ls += ex2(sink2 - m);
        const float inv = __builtin_amdgcn_rcpf(ls);
        f32x4 o[4];
#pragma unroll
        for (int i = 0; i < 4; ++i) o[i] = (f32x4){0.f, 0.f, 0.f, 0.f};
#pragma unroll
        for (int pr = 0; pr < 5; ++pr) {
            h8 bp;
#pragma unroll
            for (int e = 0; e < 4; ++e) { bp[e] = (half_t)s[2 * pr][e]; bp[4 + e] = (pr < 4) ? (half_t)s[(pr < 4) ? 2 * pr + 1 : 0][e] : (half_t)0.f; }
#pragma unroll
            for (int mt = 0; mt < 4; ++mt) { const LAS half_t* vp = Vs + ((wave + 2 * pr) * 16 + 4 * g + q) * SSTR + mt * 16 + 4 * pp;
                const h8 af = cat8(tr_read(vp), tr_read(vp + 16 * SSTR));
                o[mt] = __builtin_amdgcn_mfma_f32_16x16x32_f16(af, bp, o[mt], 0, 0, 0); }
        }
#pragma unroll
        for (int mt = 0; mt < 4; ++mt) { const int col = hq * 64 + mt * 16 + 4 * g;
            const h4 sg = *(const h4*)(PR + (size_t)tok * NIN + C_SG + col);
            h4 y;
#pragma unroll
            for (int e = 0; e < 4; ++e) y[e] = op16(o[mt][e] * inv * siluf((float)sg[e]), TAIL_BF16);
            *(h4*)(RA + (size_t)tok * 4096 + 2048 + col) = y; }
    }
    __syncthreads();
}

#define XB_TMO      128
#define XB_XCNT(j)  (256  + 64 * (j))
#define XB_XSUB(j)  (1280 + 64 * (j))
#define XB_XGEN(j)  (2304 + 64 * (j))
#define XB_TOP      3328
#define XB_TOPGEN   3392
#define XCD_BAR_WORDS 3456
#define XB_SPIN_CAP (1u << 18)

__device__ __forceinline__ unsigned xb_ld(unsigned* p)              { return __hip_atomic_load(p, __ATOMIC_RELAXED, __HIP_MEMORY_SCOPE_AGENT); }
__device__ __forceinline__ unsigned xb_add(unsigned* p, unsigned v) { return __hip_atomic_fetch_add(p, v, __ATOMIC_RELAXED, __HIP_MEMORY_SCOPE_AGENT); }
__device__ __forceinline__ unsigned xb_xcc_id() { return (unsigned)__builtin_amdgcn_s_getreg((3 << 11) | 20) & 0xFu; }
#define XB_SPIN(cond, bar) do { unsigned _sp = 0; while (cond) { __builtin_amdgcn_s_sleep(1); \
    if ((++_sp & 255u) == 0u) { if (xb_ld(&(bar)[XB_TMO])) break; if (_sp > XB_SPIN_CAP) { atomicAdd(&(bar)[XB_TMO], 1u); break; } } } } while (0)

struct XcdBarrier {
    unsigned* bar; unsigned x;
    volatile LAS unsigned* st;
};

__device__ __forceinline__ XcdBarrier xcd_barrier_post(unsigned* bar, volatile LAS unsigned* st) {
    XcdBarrier b; b.bar = bar; b.x = xb_xcc_id(); b.st = st;
    if (threadIdx.x == 0) (void)xb_add(&bar[XB_XCNT(b.x)], 1u);
    return b;
}
__device__ __forceinline__ void xcd_barrier_complete(unsigned* bar, unsigned x, unsigned& nloc, unsigned& nx) {
    const unsigned G = gridDim.x * gridDim.y * gridDim.z;
    unsigned sum, cnt, mine, sp = 0u;
    for (;;) {
        sum = 0u; cnt = 0u; mine = 0u;
#pragma unroll
        for (unsigned j = 0; j < 16; ++j) { const unsigned c = xb_ld(&bar[XB_XCNT(j)]); sum += c; cnt += (c > 0u) ? 1u : 0u; mine = (j == x) ? c : mine; }
        if (sum == G) break;
        __builtin_amdgcn_s_sleep(1);
        if ((++sp & 255u) == 0u) { if (xb_ld(&bar[XB_TMO])) break; if (sp > XB_SPIN_CAP) { atomicAdd(&bar[XB_TMO], 1u); break; } }
    }
    nloc = mine > 0u ? mine : 1u; nx = cnt > 0u ? cnt : 1u;
}

__device__ __forceinline__ void xcd_barrier(const XcdBarrier& b) {
    asm volatile("s_waitcnt vmcnt(0)" ::: "memory");
    __syncthreads();
    if (threadIdx.x == 0) {
        unsigned* bar = b.bar;
        __builtin_amdgcn_s_waitcnt(0);
        unsigned nloc = b.st[0], nx = b.st[1];
        if (nloc == 0u) { xcd_barrier_complete(bar, b.x, nloc, nx); b.st[0] = nloc; b.st[1] = nx; }
        const unsigned old = xb_add(&bar[XB_XSUB(b.x)], 1u);
        const unsigned gen = old / nloc;
        if (old + 1u == (gen + 1u) * nloc) {
            __builtin_amdgcn_fence(__ATOMIC_RELEASE, "agent");
            asm volatile("s_waitcnt vmcnt(0)" ::: "memory");
            const unsigned og = xb_add(&bar[XB_TOP], 1u);
            const unsigned tg = og / nx;
            if (og + 1u == (tg + 1u) * nx) xb_add(&bar[XB_TOPGEN], 1u);
            else XB_SPIN(xb_ld(&bar[XB_TOPGEN]) == tg, bar);
            __builtin_amdgcn_fence(__ATOMIC_ACQUIRE, "agent");
            xb_add(&bar[XB_XGEN(b.x)], 1u);
            asm volatile("s_waitcnt vmcnt(0)" ::: "memory");
        } else {
            XB_SPIN(xb_ld(&bar[XB_XGEN(b.x)]) == gen, bar);
            __builtin_amdgcn_fence(__ATOMIC_ACQUIRE, "agent");
            asm volatile("s_waitcnt vmcnt(0)" ::: "memory");
        }
    }
    __syncthreads();
}

__global__ void __launch_bounds__(512, 2) hybrid_fwd(Params p) {
    extern __shared__ __attribute__((aligned(16))) unsigned char shm[];
    LAS unsigned char* lds = (LAS unsigned char*)shm;
    cg::grid_group grid = cg::this_grid();
    const int tid = threadIdx.x, G = gridDim.x;
    unsigned char* ws = p.ws;
    volatile LAS unsigned* ctlw = (volatile LAS unsigned*)(lds + 131072);
    if (tid < 64) ctlw[tid] = 0u;
    __syncthreads();
    const XcdBarrier xbar = xcd_barrier_post((unsigned*)(ws + WS_BAR), ctlw + 8);
#define GRID_BAR() xcd_barrier(xbar)

#define LAUNDER() int t2 = tid; asm volatile("" : "+v"(t2)); const int w2 = __builtin_amdgcn_readfirstlane(t2 >> 6), l2 = t2 & 63; (void)w2; (void)l2;
    { LAUNDER(); phase_prep(p, lds, t2, w2, l2, G); }
    if (G == 0x7fffffff) grid.sync();
    GRID_BAR();
    for (int l = 0; l < DEPTH; ++l) {
        { LAUNDER(); if (l == 0) phase_u(p, 0, p.x, w2, l2, G); else phase_u_h(p, l, w2, l2, G); }
        GRID_BAR();
        { LAUNDER();
          const bool side = (G == 256); const int GG = side ? 240 : G;
          if ((int)blockIdx.x < GG) {
              pg8::Gemm gm{(const half_t*)(ws + WS_U), (const half_t*)(ws + WS_WIN + l * SZ_WIN), NTOK, NIN, DM}; pg8::StaticOrder S; S.init(NTOK, NIN, GG, blockIdx.x);
              EpiProj E{(half_t*)(ws + WS_PROJ)}; pg8::gemm_phase<EpiProj>(lds, gm, S, E, t2);
          } else {
              if (l + 1 < DEPTH) convert_range(p, l + 1, 0, I_IN, (LAS float*)(lds + w2 * 8704), ((int)blockIdx.x - GG) * 8 + w2, (G - GG) * 8, l2);
              else convert_range(p, l, I_IN, I_IN + I_SMALL, (LAS float*)(lds + w2 * 8704), ((int)blockIdx.x - GG) * 8 + w2, (G - GG) * 8, l2);
          } }
        GRID_BAR();
        { LAUNDER(); for (int it = blockIdx.x; it < 1024; it += G) { if (it < 512) { if (((it >> 3) & 31) == 0) swa_item<true>(p, l, lds, it, t2, w2, l2); else swa_item<false>(p, l, lds, it, t2, w2, l2); } else ret_kv_item(p, lds, it - 512, t2, w2, l2); } }
        GRID_BAR();
        { LAUNDER(); phase_scan(p, t2, G); }
        GRID_BAR();
        { LAUNDER(); for (int it = blockIdx.x; it < 512; it += G) ret_out_item(p, l, lds, it, t2, w2, l2); }
        GRID_BAR();
        { LAUNDER(); pg8::Gemm gm{(const half_t*)(ws + WS_RA), (const half_t*)(ws + WS_WMRG + l * SZ_WMRG), NTOK, DM, 4096}; pg8::StaticOrder S; S.init(NTOK, DM, G, blockIdx.x);
          EpiMerge E{(const half_t*)(ws + WS_PROJ), (half_t*)(ws + WS_MRG)}; pg8::gemm_phase<EpiMerge>(lds, gm, S, E, t2); }
        GRID_BAR();
        { LAUNDER(); pg8::Gemm gm{(const half_t*)(ws + WS_MRG), (const half_t*)(ws + WS_WOUT + l * SZ_WOUT), NTOK, DM, DM}; pg8::StaticOrder S; S.init(NTOK, DM, G, blockIdx.x);
          const float* gatep = (const float*)(ws + WS_MOD) + (size_t)l * 2 * 6144 + 4096;
          if (l == 0) { EpiOut<true> E{p.x, gatep, (half_t*)(ws + WS_H)}; pg8::gemm_phase<EpiOut<true>>(lds, gm, S, E, t2); }
          else { EpiOut<false> E{nullptr, gatep, (half_t*)(ws + WS_H)}; pg8::gemm_phase<EpiOut<false>>(lds, gm, S, E, t2); } }
        GRID_BAR();
    }
    { LAUNDER(); phase_final(p, w2, l2, G); }
}

extern "C" void kernel_launch(void* const* d_in, const int* in_sizes, int n_in, void* d_out, int out_size, void* d_ws, size_t ws_size, hipStream_t stream) {
    static int grid = 0;
    if (grid == 0) {
        if (n_in != 12 || out_size != NTOK * DM || ws_size < WS_END) { fprintf(stderr, "kernel_launch: unexpected shapes / workspace (%d inputs, out %d, ws %zu < %zu)\n", n_in, out_size, ws_size, (size_t)WS_END); grid = -1; return; }
        int dev = 0, cus = 0, per_cu = 0;
        (void)hipGetDevice(&dev);
        (void)hipDeviceGetAttribute(&cus, hipDeviceAttributeMultiprocessorCount, dev);
        if (hipFuncSetAttribute((const void*)hybrid_fwd, hipFuncAttributeMaxDynamicSharedMemorySize, LDS_BYTES) != hipSuccess) { fprintf(stderr, "kernel_launch: hipFuncSetAttribute failed\n"); grid = -1; return; }
        if (hipOccupancyMaxActiveBlocksPerMultiprocessor(&per_cu, (const void*)hybrid_fwd, 512, LDS_BYTES) != hipSuccess || per_cu < 1) { fprintf(stderr, "kernel_launch: occupancy query failed (%d)\n", per_cu); per_cu = 1; }
        (void)hipGetLastError();
        grid = cus * per_cu;
        fprintf(stderr, "kernel_launch: grid %d (%d CUs x %d)\n", grid, cus, per_cu);
    }
    if (grid < 0) return;
    Params p{};
    p.x = (const float*)d_in[0]; p.c = (const float*)d_in[1]; p.norm_w = (const float*)d_in[2]; p.ada_w = (const float*)d_in[3]; p.ada_b = (const float*)d_in[4];
    p.w_in = (const float*)d_in[5]; p.gn_w = (const float*)d_in[6]; p.sinks = (const float*)d_in[7]; p.w_ret_o = (const float*)d_in[8]; p.w_swa_o = (const float*)d_in[9];
    p.w_out = (const float*)d_in[10]; p.fnorm_w = (const float*)d_in[11]; p.out = (float*)d_out; p.ws = (unsigned char*)d_ws;
    if (hipMemsetAsync((unsigned char*)d_ws + WS_BAR, 0, 16384, stream) != hipSuccess) { fprintf(stderr, "kernel_launch: memset of barrier words failed\n"); return; }
    void* args[] = {&p};
    hipError_t e = hipLaunchCooperativeKernel((const void*)hybrid_fwd, dim3(grid), dim3(512), args, LDS_BYTES, stream);
    if (e != hipSuccess) fprintf(stderr, "kernel_launch: cooperative launch failed: %s (grid %d)\n", hipGetErrorString(e), grid);
}
```
